# Optimizing an MI355X kernel written in HIP

```python
import jax
import jax.numpy as jnp
from jax import lax
import numpy as np

D_MODEL = 1024
BATCH = 4
SEQ = 4096
DEPTH = 1

GRID_W = 64
CTX_LEN = 256
HEAD_DIM = 128
N_Q_HEADS = 8
N_KV_HEADS = 2
Q_PER_KV = N_Q_HEADS // N_KV_HEADS
Q_BLOCK = 128
ROPE_THETA = 10000.0
GLA_HEADS = 4
GLA_DK = D_MODEL // (2 * GLA_HEADS)
GLA_DV = D_MODEL // GLA_HEADS
GLA_GATE_RANK = 16
GLA_GATE_NORM = 16.0
GLA_CHUNK = 64
D_FF = 4 * D_MODEL
EPS = 1e-6

IN_SIZES = (
    N_KV_HEADS * HEAD_DIM,
    N_KV_HEADS * HEAD_DIM,
    GLA_HEADS * GLA_DK,
    GLA_HEADS * GLA_DV,
    GLA_GATE_RANK,
    GLA_GATE_RANK,
    N_Q_HEADS * HEAD_DIM,
    GLA_HEADS * GLA_DK,
    GLA_HEADS * GLA_DV,
    D_MODEL,
    D_MODEL,
)
N_CTX_GROUPS = 6
D_IN = int(sum(IN_SIZES))
IN_OFFSETS = tuple(int(o) for o in np.cumsum(IN_SIZES)[:-1])
CTX_COLS = int(sum(IN_SIZES[:N_CTX_GROUPS]))

kernel_name = 'hybrid_gqa_gla_dit_layer'


def rms_norm(x, g):
    xf = x.astype(jnp.float32)
    y = xf * lax.rsqrt(jnp.mean(xf * xf, axis=-1, keepdims=True) + EPS)
    return (y * g.astype(jnp.float32)).astype(x.dtype)


def modulate(h, shift, scale):
    return h * (1 + scale[..., None, :]) + shift[..., None, :]


def split_heads(a, n_heads, d):
    return a.reshape(*a.shape[:-1], n_heads, d)


def axial_rope_tables(n_rows):
    rows = jnp.repeat(jnp.arange(n_rows), GRID_W).astype(jnp.float32)
    cols = jnp.tile(jnp.arange(GRID_W), n_rows).astype(jnp.float32)
    half = HEAD_DIM // 2
    freqs = ROPE_THETA ** (-jnp.arange(0, half, 2, dtype=jnp.float32) / half)
    ang = jnp.stack([rows[:, None] * freqs, cols[:, None] * freqs], axis=1)
    return jnp.cos(ang)[None, :, None], jnp.sin(ang)[None, :, None]


def apply_rope(x, cos, sin):
    xf = x.astype(jnp.float32).reshape(*x.shape[:-1], 2, 2, HEAD_DIM // 4)
    a, b = xf[..., 0, :], xf[..., 1, :]
    out = jnp.stack([a * cos - b * sin, b * cos + a * sin], axis=-2)
    return out.reshape(x.shape).astype(x.dtype)


def gqa_attention(q, k, v):
    b, t = q.shape[:2]
    qb = jnp.moveaxis(q.reshape(b, t // Q_BLOCK, Q_BLOCK, N_KV_HEADS, Q_PER_KV, HEAD_DIM), 1, 0)

    def one_block(q_blk):
        s = jnp.einsum('bqhgd,bkhd->bhgqk', q_blk, k, preferred_element_type=jnp.float32) * (HEAD_DIM ** -0.5)
        p = jax.nn.softmax(s, axis=-1).astype(v.dtype)
        return jnp.einsum('bhgqk,bkhd->bqhgd', p, v)

    o = lax.map(one_block, qb)
    return jnp.moveaxis(o, 0, 1).reshape(b, t, N_Q_HEADS * HEAD_DIM)


def gla_heads(a, d):
    return jnp.moveaxis(split_heads(a.astype(jnp.float32), GLA_HEADS, d), 2, 1)


def gla_log_decay(lowrank, w_gk, b_gk):
    g = jax.nn.log_sigmoid((lowrank @ w_gk + b_gk).astype(jnp.float32)) / GLA_GATE_NORM
    return gla_heads(g, GLA_DK)


def flip_t(a):
    return a[:, :, ::-1]


def gla_chunked(q, k, v, g, s0):
    b_, h_, t, _ = q.shape
    n = t // GLA_CHUNK

    def to_chunks(a):
        return jnp.moveaxis(a.reshape(b_, h_, n, GLA_CHUNK, a.shape[-1]), 2, 0)

    mask = jnp.tril(jnp.ones((GLA_CHUNK, GLA_CHUNK), dtype=bool))[:, :, None]

    def step(state, inp):
        qc, kc, vc, gc = inp
        b = jnp.cumsum(gc, axis=2)
        o_inter = jnp.einsum('bhid,bhde->bhie', qc * jnp.exp(b), state)
        diff = jnp.where(mask, b[:, :, :, None, :] - b[:, :, None, :, :], -jnp.inf)
        a = jnp.einsum('bhid,bhjd,bhijd->bhij', qc, kc, jnp.exp(diff))
        o = o_inter + jnp.einsum('bhij,bhje->bhie', a, vc)
        b_last = b[:, :, -1:, :]
        state = jnp.exp(b_last[:, :, 0, :])[..., None] * state + jnp.einsum('bhjd,bhje->bhde', kc * jnp.exp(b_last - b), vc)
        return state, o

    s_fin, o = lax.scan(step, s0, (to_chunks(q), to_chunks(k), to_chunks(v), to_chunks(g)))
    o = jnp.moveaxis(o, 0, 2).reshape(b_, h_, t, v.shape[-1])
    return o, s_fin


def gla_final_state(k, v, g):
    b = jnp.cumsum(g, axis=2)
    return jnp.einsum('bhtd,bhte->bhde', k * jnp.exp(b[:, :, -1:] - b), v)


def gla_output(o, gate, g_norm):
    o = jnp.moveaxis(o, 1, 2)
    y = rms_norm(o, g_norm) * jax.nn.silu(split_heads(gate, GLA_HEADS, GLA_DV).astype(jnp.float32))
    return y.reshape(*y.shape[:2], GLA_HEADS * GLA_DV).astype(gate.dtype)


def branch_merge(attn, gla, gate_a, gate_g, w_br_attn, w_br_gla, w_out):
    y = jax.nn.sigmoid(gate_a) * (attn @ w_br_attn) + jax.nn.sigmoid(gate_g) * (gla @ w_br_gla)
    return y @ w_out


def sq_relu_mlp(h, w1, w2):
    return jnp.square(jax.nn.relu(h @ w1)) @ w2


def hybrid_layer(x, ctx, mod_x, mod_c, rope, norm1, w_in, q_norm, k_norm, w_gk_fwd, b_gk_fwd,
                 w_gk_bwd, b_gk_bwd, gla_norm, w_br_attn, w_br_gla, w_out, norm2, w_mlp1, w_mlp2,
                 update_ctx):
    cos, sin = rope
    sh1, sc1, gt1, sh2, sc2, gt2 = mod_x
    bsz = x.shape[0]
    hx = modulate(rms_norm(x, norm1), sh1, sc1)
    hc = modulate(rms_norm(ctx, norm1), mod_c[0], mod_c[1])
    ak, av, gk, gv, lrf, lrb, aq, gq, go, ga, gg = jnp.split(hx @ w_in, IN_OFFSETS, axis=-1)
    if update_ctx:
        ak_c, av_c, gk_c, gv_c, lrf_c, lrb_c, aq_c, gq_c, go_c, ga_c, gg_c = jnp.split(hc @ w_in, IN_OFFSETS, axis=-1)
    else:
        ak_c, av_c, gk_c, gv_c, lrf_c, lrb_c = jnp.split(hc @ w_in[:, :CTX_COLS], IN_OFFSETS[:N_CTX_GROUPS - 1], axis=-1)

    qx = apply_rope(rms_norm(split_heads(aq, N_Q_HEADS, HEAD_DIM), q_norm), cos, sin)
    kx = apply_rope(rms_norm(split_heads(ak, N_KV_HEADS, HEAD_DIM), k_norm), cos, sin)
    vx = split_heads(av, N_KV_HEADS, HEAD_DIM)
    kc = rms_norm(split_heads(ak_c, N_KV_HEADS, HEAD_DIM), k_norm)
    vc = split_heads(av_c, N_KV_HEADS, HEAD_DIM)
    attn_x = gqa_attention(qx, jnp.concatenate([kx, kc], axis=1), jnp.concatenate([vx, vc], axis=1))

    kgc, vgc = gla_heads(gk_c, GLA_DK), gla_heads(gv_c, GLA_DV)
    gfc = gla_log_decay(lrf_c, w_gk_fwd, b_gk_fwd)
    gbc = gla_log_decay(lrb_c, w_gk_bwd, b_gk_bwd)
    if update_ctx:
        zeros = jnp.zeros((bsz, GLA_HEADS, GLA_DK, GLA_DV), jnp.float32)
        qgc = gla_heads(gq_c, GLA_DK) * (GLA_DK ** -0.5)
        oc_f, s_f = gla_chunked(qgc, kgc, vgc, gfc, zeros)
        oc_b, s_b = gla_chunked(flip_t(qgc), flip_t(kgc), flip_t(vgc), flip_t(gbc), zeros)
    else:
        s_f = gla_final_state(kgc, vgc, gfc)
        s_b = gla_final_state(flip_t(kgc), flip_t(vgc), flip_t(gbc))
    qgx = gla_heads(gq, GLA_DK) * (GLA_DK ** -0.5)
    kgx, vgx = gla_heads(gk, GLA_DK), gla_heads(gv, GLA_DV)
    gfx = gla_log_decay(lrf, w_gk_fwd, b_gk_fwd)
    gbx = gla_log_decay(lrb, w_gk_bwd, b_gk_bwd)
    ox_f, _ = gla_chunked(qgx, kgx, vgx, gfx, s_f)
    ox_b, _ = gla_chunked(flip_t(qgx), flip_t(kgx), flip_t(vgx), flip_t(gbx), s_b)
    gla_x = gla_output(ox_f + flip_t(ox_b), go, gla_norm)

    x = x + gt1[..., None, :] * branch_merge(attn_x, gla_x, ga, gg, w_br_attn, w_br_gla, w_out)
    x = x + gt2[..., None, :] * sq_relu_mlp(modulate(rms_norm(x, norm2), sh2, sc2), w_mlp1, w_mlp2)

    if update_ctx:
        _, _, gt1c, sh2c, sc2c, gt2c = mod_c
        qc = rms_norm(split_heads(aq_c, N_Q_HEADS, HEAD_DIM), q_norm)
        attn_c = gqa_attention(qc, kc, vc)
        gla_c = gla_output(oc_f + flip_t(oc_b), go_c, gla_norm)
        ctx = ctx + gt1c[..., None, :] * branch_merge(attn_c, gla_c, ga_c, gg_c, w_br_attn, w_br_gla, w_out)
        ctx = ctx + gt2c[..., None, :] * sq_relu_mlp(modulate(rms_norm(ctx, norm2), sh2c, sc2c), w_mlp1, w_mlp2)
    return x, ctx


def setup_inputs(seed: int = 0) -> dict:
    key = jax.random.key(seed)
    ks = jax.random.split(key, 24)
    f32 = jnp.float32

    def nrm(k, shape, scale=1.0):
        return jax.random.normal(k, shape, f32) * scale

    L, D = DEPTH, D_MODEL
    return {
        'x': nrm(ks[0], (BATCH, SEQ, D)),
        'c': nrm(ks[1], (BATCH, D)),
        'ctx': nrm(ks[2], (BATCH, CTX_LEN, D)),
        'c_ctx': nrm(ks[3], (D,)),
        'w_ada': nrm(ks[4], (L, D, 6 * D), 0.5 * D ** -0.5),
        'b_ada': nrm(ks[5], (L, 6 * D), 0.02),
        'norm1': 1.0 + nrm(ks[6], (L, D), 0.02),
        'w_in': nrm(ks[7], (L, D, D_IN), D ** -0.5),
        'q_norm': 1.0 + nrm(ks[8], (L, HEAD_DIM), 0.02),
        'k_norm': 1.0 + nrm(ks[9], (L, HEAD_DIM), 0.02),
        'w_gk_fwd': nrm(ks[10], (L, GLA_GATE_RANK, GLA_HEADS * GLA_DK), GLA_GATE_RANK ** -0.5),
        'b_gk_fwd': nrm(ks[11], (L, GLA_HEADS * GLA_DK), 0.1),
        'w_gk_bwd': nrm(ks[12], (L, GLA_GATE_RANK, GLA_HEADS * GLA_DK), GLA_GATE_RANK ** -0.5),
        'b_gk_bwd': nrm(ks[13], (L, GLA_HEADS * GLA_DK), 0.1),
        'gla_norm': 1.0 + nrm(ks[14], (L, GLA_DV), 0.02),
        'w_br_attn': nrm(ks[15], (L, N_Q_HEADS * HEAD_DIM, D), (N_Q_HEADS * HEAD_DIM) ** -0.5),
        'w_br_gla': nrm(ks[16], (L, GLA_HEADS * GLA_DV, D), (GLA_HEADS * GLA_DV) ** -0.5),
        'w_out': nrm(ks[17], (L, D, D), D ** -0.5),
        'norm2': 1.0 + nrm(ks[18], (L, D), 0.02),
        'w_mlp1': nrm(ks[19], (L, D, D_FF), D ** -0.5),
        'w_mlp2': nrm(ks[20], (L, D_FF, D), D_FF ** -0.5),
    }


def reference(x, c, ctx, c_ctx, w_ada, b_ada, norm1, w_in, q_norm, k_norm, w_gk_fwd, b_gk_fwd,
              w_gk_bwd, b_gk_bwd, gla_norm, w_br_attn, w_br_gla, w_out, norm2, w_mlp1, w_mlp2):
    ROWS = x.shape[1] // GRID_W
    rope = axial_rope_tables(ROWS)
    for l in range(DEPTH):
        update_ctx = l < DEPTH - 1
        n_mod = 6 if update_ctx else 2
        mod_x = jnp.split(jax.nn.silu(c) @ w_ada[l] + b_ada[l], 6, axis=-1)
        mod_c = jnp.split(jax.nn.silu(c_ctx) @ w_ada[l][:, :n_mod * D_MODEL] + b_ada[l][:n_mod * D_MODEL], n_mod, axis=-1)
        x, ctx = hybrid_layer(x, ctx, mod_x, mod_c, rope, norm1[l], w_in[l], q_norm[l], k_norm[l],
                              w_gk_fwd[l], b_gk_fwd[l], w_gk_bwd[l], b_gk_bwd[l], gla_norm[l],
                              w_br_attn[l], w_br_gla[l], w_out[l], norm2[l], w_mlp1[l], w_mlp2[l],
                              update_ctx)
    return x
```

```cpp
#include <hip/hip_runtime.h>
#include <cstdio>
#include <cstdint>

typedef unsigned short bf16_t;
typedef short bf16x8 __attribute__((ext_vector_type(8)));
typedef float f32x4 __attribute__((ext_vector_type(4)));

constexpr int NB = 4, T = 4096, DM = 1024, CTX = 256, P = CTX + T  ;
constexpr int M = NB * T, MC = NB * CTX, MALL = M + MC;
constexpr int NIN = 6656;
constexpr int FF = 4096;
constexpr float EPS = 1e-6f;

constexpr size_t MiB = 1u << 20;
constexpr size_t WS_CTL = 0;
constexpr size_t WS_MODX = 1 * MiB, WS_MODC = 1 * MiB + 128 * 1024, WS_ROPE = 1 * MiB + 192 * 1024;
constexpr size_t WS_WIN = 4 * MiB, WS_WA = 18 * MiB, WS_WG = 20 * MiB, WS_WO = 22 * MiB, WS_W1 = 24 * MiB, WS_W2 = 32 * MiB;
constexpr size_t WS_KA = 40 * MiB, WS_VA = WS_KA + (size_t)NB * P * 256 * 2, WS_GK = 57 * MiB, WS_GV = 74 * MiB, WS_LR = 108 * MiB;
constexpr size_t WS_QA = 111 * MiB, WS_GQ = 143 * MiB, WS_GO = 159 * MiB, WS_GA = 191 * MiB, WS_GG = 223 * MiB;
constexpr size_t WS_Y = 74 * MiB, WS_HN = 191 * MiB, WS_H = 40 * MiB;
static_assert(WS_VA + (size_t)NB * P * 256 * 2 <= WS_GK, "map");

__device__ __forceinline__ unsigned f2bf(float f) { unsigned u = __builtin_bit_cast(unsigned, f); return (u + 0x7fffu + ((u >> 16) & 1u)) >> 16; }
__device__ __forceinline__ float bf2f(bf16_t h) { return __builtin_bit_cast(float, (unsigned)h << 16); }
__device__ __forceinline__ float wave_sum(float v) {
#pragma unroll
    for (int o = 1; o < 64; o <<= 1) v += __shfl_xor(v, o);
    return v;
}
__device__ __forceinline__ float sigmoidf_(float x) { return 1.f / (1.f + __expf(-x)); }
__device__ __forceinline__ size_t prow(int m) {
    if (m < M) { const int b = m >> 12, t = m & 4095; return (size_t)b * P + CTX + t; }
    const int mc = m - M; const int b = mc >> 8, s = mc & 255; return (size_t)b * P + s;
}

__device__ __forceinline__ int win_src_col(int nd) {
    if (nd < 2048) return nd;
    if (nd < 6656) return nd + 32;
    if (nd < 6688) return 2048 + (nd - 6656);
    return -1;
}
__global__ void k_convT(const float* __restrict__ W, int K, int N, bf16_t* __restrict__ out, int ndst, int mode) {
    const size_t idx = (size_t)blockIdx.x * 256 + threadIdx.x;
    if (idx >= (size_t)ndst * K) return;
    const int nd = (int)(idx % ndst), k = (int)(idx / ndst);
    const int ns = mode ? win_src_col(nd) : nd;
    const float v = ns >= 0 ? W[(size_t)k * N + ns] : 0.f;
    out[(size_t)nd * K + k] = (bf16_t)f2bf(v);
}
__global__ void k_adaln(const float* __restrict__ c, const float* __restrict__ c_ctx, const float* __restrict__ w_ada, const float* __restrict__ b_ada,
                        float* __restrict__ modx, float* __restrict__ modc) {
    const int j = blockIdx.x * 256 + threadIdx.x, r = blockIdx.y;
    if (j >= 6 * DM) return;
    if (r == 4 && j >= 2 * DM) return;
    const float* cv = r < 4 ? c + r * DM : c_ctx;
    float acc = 0.f;
    for (int k = 0; k < DM; ++k) { const float x = cv[k]; acc += (x / (1.f + expf(-x))) * w_ada[(size_t)k * 6 * DM + j]; }
    acc += b_ada[j];
    if (r < 4) modx[r * 6 * DM + j] = acc; else modc[j] = acc;
}
__global__ void k_rope_table(float* __restrict__ rope) {
    const int i = blockIdx.x * 256 + threadIdx.x; if (i >= 64 * 32) return;
    const int pos = i >> 5, f = i & 31;
    const float freq = powf(10000.f, -(float)(2 * f) / 64.f);
    const float ang = (float)pos * freq;
    rope[2 * i] = cosf(ang); rope[2 * i + 1] = sinf(ang);
}
__global__ void k_norm_mod(const float* __restrict__ X, int nrows, int rows_per_batch, const float* __restrict__ gw,
                           const float* __restrict__ mod, int mod_bstride, int sh_off, int sc_off, bf16_t* __restrict__ out) {
    const int row = blockIdx.x * 4 + (threadIdx.x >> 6), lane = threadIdx.x & 63;
    if (row >= nrows) return;
    const int b = row / rows_per_batch;
    const float* xr = X + (size_t)row * DM; const float* sh = mod + (size_t)b * mod_bstride + sh_off; const float* sc = mod + (size_t)b * mod_bstride + sc_off;
    float v[16]; float s = 0.f;
#pragma unroll
    for (int i = 0; i < 16; ++i) { v[i] = xr[lane + 64 * i]; s += v[i] * v[i]; }
    const float r = rsqrtf(wave_sum(s) * (1.f / DM) + EPS);
#pragma unroll
    for (int i = 0; i < 16; ++i) { const int k = lane + 64 * i; const float y = v[i] * r * gw[k]; out[(size_t)row * DM + k] = (bf16_t)f2bf(y * (1.f + sc[k]) + sh[k]); }
}

template <class Epi>
__global__ __launch_bounds__(256) void k_gemm_simple(const bf16_t* __restrict__ A, const bf16_t* __restrict__ Bt, int K, int m_off, Epi epi) {
    const int wave = threadIdx.x >> 6, lane = threadIdx.x & 63, fr = lane & 15, fq = lane >> 4;
    const int m0 = blockIdx.y * 64 + (wave >> 1) * 32, n0 = blockIdx.x * 64 + (wave & 1) * 32;
    f32x4 acc[2][2];
#pragma unroll
    for (int i = 0; i < 2; ++i)
#pragma unroll
        for (int j = 0; j < 2; ++j) acc[i][j] = (f32x4){0.f, 0.f, 0.f, 0.f};
    for (int k0 = 0; k0 < K; k0 += 32) {
        bf16x8 a[2], b[2];
#pragma unroll
        for (int i = 0; i < 2; ++i) a[i] = *(const bf16x8*)(A + (size_t)(m0 + i * 16 + fr) * K + k0 + fq * 8);
#pragma unroll
        for (int j = 0; j < 2; ++j) b[j] = *(const bf16x8*)(Bt + (size_t)(n0 + j * 16 + fr) * K + k0 + fq * 8);
#pragma unroll
        for (int i = 0; i < 2; ++i)
#pragma unroll
            for (int j = 0; j < 2; ++j) acc[i][j] = __builtin_amdgcn_mfma_f32_16x16x32_bf16(a[i], b[j], acc[i][j], 0, 0, 0);
    }
#pragma unroll
    for (int i = 0; i < 2; ++i)
#pragma unroll
        for (int j = 0; j < 2; ++j)
#pragma unroll
            for (int r = 0; r < 4; ++r) epi(m_off + m0 + i * 16 + fq * 4 + r, n0 + j * 16 + fr, acc[i][j][r]);
}
struct EpiIn {
    bf16_t *KA, *VA, *GK, *GV, *QA, *GQ, *GO, *GA, *GG;
    __device__ __forceinline__ void operator()(int m, int n, float v) const {
        const size_t pr = prow(m);
        if (n < 256) { KA[pr * 256 + n] = (bf16_t)f2bf(v); return; }
        if (n < 512) { VA[pr * 256 + (n - 256)] = (bf16_t)f2bf(v); return; }
        if (n < 1024) { GK[pr * 512 + (n - 512)] = (bf16_t)f2bf(v); return; }
        if (n < 2048) { GV[pr * 1024 + (n - 1024)] = (bf16_t)f2bf(v); return; }
        if (m >= M) return;
        if (n < 3072) { QA[(size_t)m * 1024 + (n - 2048)] = (bf16_t)f2bf(v); return; }
        if (n < 3584) { GQ[(size_t)m * 512 + (n - 3072)] = (bf16_t)f2bf(v * 0.08838834764831845f); return; }
        if (n < 4608) { GO[(size_t)m * 1024 + (n - 3584)] = (bf16_t)f2bf(v); return; }
        if (n < 5632) { GA[(size_t)m * 1024 + (n - 4608)] = (bf16_t)f2bf(v); return; }
        GG[(size_t)m * 1024 + (n - 5632)] = (bf16_t)f2bf(v);
    }
};
struct EpiLR { float* LR; __device__ __forceinline__ void operator()(int m, int n, float v) const { if (n < 32) LR[prow(m) * 32 + n] = v; } };
struct EpiMerge1 { const bf16_t* G; bf16_t* Y; __device__ __forceinline__ void operator()(int m, int n, float v) const {
    const size_t i = (size_t)m * 1024 + n; Y[i] = (bf16_t)f2bf(sigmoidf_(bf2f(G[i])) * v); } };
struct EpiMerge2 { const bf16_t* G; bf16_t* Y; __device__ __forceinline__ void operator()(int m, int n, float v) const {
    const size_t i = (size_t)m * 1024 + n; Y[i] = (bf16_t)f2bf(bf2f(Y[i]) + sigmoidf_(bf2f(G[i])) * v); } };
struct EpiRes { const float* base; float* out; const float* modx; int gt_off; __device__ __forceinline__ void operator()(int m, int n, float v) const {
    const size_t i = (size_t)m * 1024 + n; out[i] = base[i] + modx[(m >> 12) * 6 * DM + gt_off + n] * v; } };
struct EpiMlp1 { bf16_t* H; __device__ __forceinline__ void operator()(int m, int n, float v) const { const float r = v > 0.f ? v : 0.f; H[(size_t)m * FF + n] = (bf16_t)f2bf(r * r); } };

__global__ void k_qknorm_rope(bf16_t* __restrict__ buf, int nrows, int nheads, int pitch, const float* __restrict__ gw, const float* __restrict__ rope, int mode) {
    const int wid = blockIdx.x * 4 + (threadIdx.x >> 6), lane = threadIdx.x & 63;
    if (wid >= nrows * nheads) return;
    const int row = wid / nheads, h = wid % nheads;
    bf16_t* p = buf + (size_t)row * pitch + h * 128;
    float v0 = bf2f(p[lane]), v1 = bf2f(p[64 + lane]);
    const float r = rsqrtf(wave_sum(v0 * v0 + v1 * v1) * (1.f / 128.f) + EPS);
    v0 = v0 * r * gw[lane]; v1 = v1 * r * gw[64 + lane];
    int t; bool dorope = true;
    if (mode == 0) t = row & 4095; else { const int pp = row % P; dorope = pp >= CTX; t = pp - CTX; }
    if (dorope) {
        const int prow_ = t >> 6, pcol = t & 63, f = lane & 31, hf = lane >> 5;
        const float c0 = rope[2 * (prow_ * 32 + f)], s0 = rope[2 * (prow_ * 32 + f) + 1];
        const float c1 = rope[2 * (pcol * 32 + f)], s1 = rope[2 * (pcol * 32 + f) + 1];
        const float q0 = __shfl_xor(v0, 32), q1 = __shfl_xor(v1, 32);
        v0 = hf == 0 ? v0 * c0 - q0 * s0 : v0 * c0 + q0 * s0;
        v1 = hf == 0 ? v1 * c1 - q1 * s1 : v1 * c1 + q1 * s1;
    }
    p[lane] = (bf16_t)f2bf(v0); p[64 + lane] = (bf16_t)f2bf(v1);
}

__global__ void k_attn_naive(bf16_t* __restrict__ QA, const bf16_t* __restrict__ KA, const bf16_t* __restrict__ VA) {
    const int wid = blockIdx.x * 4 + (threadIdx.x >> 6), lane = threadIdx.x & 63;
    const int h = wid & 7, m = wid >> 3, b = m >> 12, kvh = h >> 2;
    bf16_t* qp = QA + (size_t)m * 1024 + h * 128 + 2 * lane;
    const float q0 = bf2f(qp[0]), q1 = bf2f(qp[1]);
    const bf16_t* kp = KA + (size_t)b * P * 256 + kvh * 128 + 2 * lane; const bf16_t* vp = VA + (size_t)b * P * 256 + kvh * 128 + 2 * lane;
    float mx = -1e30f, l = 0.f, a0 = 0.f, a1 = 0.f;
    for (int p = 0; p < P; ++p) {
        const unsigned kk = *(const unsigned*)(kp + (size_t)p * 256), vv = *(const unsigned*)(vp + (size_t)p * 256);
        float s = q0 * bf2f((bf16_t)(kk & 0xffff)) + q1 * bf2f((bf16_t)(kk >> 16));
        s = wave_sum(s) * 0.08838834764831845f;
        const float mn = fmaxf(mx, s), al = __expf(mx - mn), pe = __expf(s - mn);
        l = l * al + pe; a0 = a0 * al + pe * bf2f((bf16_t)(vv & 0xffff)); a1 = a1 * al + pe * bf2f((bf16_t)(vv >> 16)); mx = mn;
    }
    const float il = 1.f / l;
    qp[0] = (bf16_t)f2bf(a0 * il); qp[1] = (bf16_t)f2bf(a1 * il);
}

__device__ __forceinline__ float logsigmoidf_(float x) { return fminf(x, 0.f) - log1pf(expf(-fabsf(x))); }
__global__ __launch_bounds__(1024) void k_gla_scan_naive(const bf16_t* __restrict__ GK, const bf16_t* __restrict__ GV, const bf16_t* __restrict__ GQ, const float* __restrict__ LR,
                                                       const float* __restrict__ w_gk, const float* __restrict__ b_gk, float* __restrict__ OF, int dir) {
    __shared__ float eg[128], sk[128], sq[128], sv[256], red[4][256];
    const int bh = blockIdx.x, b = bh >> 2, h = bh & 3, tid = threadIdx.x, dv = tid & 255, dq = tid >> 8;
    float S[32];
#pragma unroll
    for (int i = 0; i < 32; ++i) S[i] = 0.f;
    for (int i = 0; i < P; ++i) {
        int p; if (dir == 0) p = i; else p = i < CTX ? (CTX - 1 - i) : CTX + (T - 1 - (i - CTX));
        const bool isx = p >= CTX; const int m = b * T + (p - CTX);
        const size_t pr = (size_t)b * P + p;
        if (tid < 128) {
            const int d = tid; float xg = b_gk[h * 128 + d];
            for (int r = 0; r < 16; ++r) xg += LR[pr * 32 + dir * 16 + r] * w_gk[r * 512 + h * 128 + d];
            eg[d] = expf(logsigmoidf_(xg) * (1.f / 16.f));
            sk[d] = bf2f(GK[pr * 512 + h * 128 + d]);
            sq[d] = isx ? bf2f(GQ[(size_t)m * 512 + h * 128 + d]) : 0.f;
        } else if (tid < 384) { const int e = tid - 128; sv[e] = bf2f(GV[pr * 1024 + h * 256 + e]); }
        __syncthreads();
        const float v = sv[dv]; float po = 0.f;
#pragma unroll
        for (int j = 0; j < 32; ++j) { const int d = dq * 32 + j; S[j] = eg[d] * S[j] + sk[d] * v; po += sq[d] * S[j]; }
        if (isx) red[dq][dv] = po;
        __syncthreads();
        if (isx && tid < 256) { const float o = (red[0][tid] + red[1][tid]) + (red[2][tid] + red[3][tid]); float* op = OF + (size_t)m * 1024 + h * 256 + tid; if (dir == 0) *op = o; else *op += o; }
    }
}
__global__ void k_gla_out_naive(const float* __restrict__ OF, bf16_t* __restrict__ GO, const float* __restrict__ gn) {
    const int wid = blockIdx.x * 4 + (threadIdx.x >> 6), lane = threadIdx.x & 63;
    const int h = wid & 3, m = wid >> 2;
    const float* op = OF + (size_t)m * 1024 + h * 256; bf16_t* gp = GO + (size_t)m * 1024 + h * 256;
    float v[4]; float s = 0.f;
#pragma unroll
    for (int i = 0; i < 4; ++i) { v[i] = op[lane + 64 * i]; s += v[i] * v[i]; }
    const float r = rsqrtf(wave_sum(s) * (1.f / 256.f) + EPS);
#pragma unroll
    for (int i = 0; i < 4; ++i) { const int e = lane + 64 * i; const float g = bf2f(gp[e]); gp[e] = (bf16_t)f2bf(v[i] * r * gn[e] * (g * sigmoidf_(g))); }
}

extern "C" void kernel_launch(void* const* d_in, const int* in_sizes, int n_in, void* d_out, int out_size, void* d_ws, size_t ws_size, hipStream_t stream) {
    (void)in_sizes; (void)n_in; (void)out_size; (void)ws_size;
    const float* x = (const float*)d_in[0]; const float* c = (const float*)d_in[1]; const float* ctx = (const float*)d_in[2]; const float* c_ctx = (const float*)d_in[3];
    const float* w_ada = (const float*)d_in[4]; const float* b_ada = (const float*)d_in[5]; const float* norm1 = (const float*)d_in[6]; const float* w_in = (const float*)d_in[7];
    const float* q_norm = (const float*)d_in[8]; const float* k_norm = (const float*)d_in[9]; const float* w_gk_f = (const float*)d_in[10]; const float* b_gk_f = (const float*)d_in[11];
    const float* w_gk_b = (const float*)d_in[12]; const float* b_gk_b = (const float*)d_in[13]; const float* gla_norm = (const float*)d_in[14]; const float* w_br_attn = (const float*)d_in[15];
    const float* w_br_gla = (const float*)d_in[16]; const float* w_out = (const float*)d_in[17]; const float* norm2 = (const float*)d_in[18]; const float* w_mlp1 = (const float*)d_in[19]; const float* w_mlp2 = (const float*)d_in[20];
    unsigned char* ws = (unsigned char*)d_ws; float* out = (float*)d_out;
    float* MODX = (float*)(ws + WS_MODX); float* MODC = (float*)(ws + WS_MODC); float* ROPE = (float*)(ws + WS_ROPE);
    bf16_t* WinT = (bf16_t*)(ws + WS_WIN); bf16_t* WaT = (bf16_t*)(ws + WS_WA); bf16_t* WgT = (bf16_t*)(ws + WS_WG); bf16_t* WoT = (bf16_t*)(ws + WS_WO);
    bf16_t* W1T = (bf16_t*)(ws + WS_W1); bf16_t* W2T = (bf16_t*)(ws + WS_W2);
    bf16_t* KA = (bf16_t*)(ws + WS_KA); bf16_t* VA = (bf16_t*)(ws + WS_VA); bf16_t* GK = (bf16_t*)(ws + WS_GK); bf16_t* GV = (bf16_t*)(ws + WS_GV); float* LR = (float*)(ws + WS_LR);
    bf16_t* QA = (bf16_t*)(ws + WS_QA); bf16_t* GQ = (bf16_t*)(ws + WS_GQ); bf16_t* GO = (bf16_t*)(ws + WS_GO); bf16_t* GA = (bf16_t*)(ws + WS_GA); bf16_t* GG = (bf16_t*)(ws + WS_GG);
    bf16_t* Y = (bf16_t*)(ws + WS_Y); bf16_t* HN = (bf16_t*)(ws + WS_HN); bf16_t* H = (bf16_t*)(ws + WS_H);
    bf16_t* XN = (bf16_t*)d_out;
    float* OF = (float*)d_out;

    auto blocks = [](size_t n) { return (unsigned)((n + 255) / 256); };
    k_convT<<<blocks((size_t)6720 * DM), 256, 0, stream>>>(w_in, DM, 6688, WinT, 6720, 1);
    k_convT<<<blocks((size_t)DM * DM), 256, 0, stream>>>(w_br_attn, DM, DM, WaT, DM, 0);
    k_convT<<<blocks((size_t)DM * DM), 256, 0, stream>>>(w_br_gla, DM, DM, WgT, DM, 0);
    k_convT<<<blocks((size_t)DM * DM), 256, 0, stream>>>(w_out, DM, DM, WoT, DM, 0);
    k_convT<<<blocks((size_t)FF * DM), 256, 0, stream>>>(w_mlp1, DM, FF, W1T, FF, 0);
    k_convT<<<blocks((size_t)FF * DM), 256, 0, stream>>>(w_mlp2, FF, DM, W2T, DM, 0);
    k_adaln<<<dim3(24, 5), 256, 0, stream>>>(c, c_ctx, w_ada, b_ada, MODX, MODC);
    k_rope_table<<<8, 256, 0, stream>>>(ROPE);
    k_norm_mod<<<M / 4, 256, 0, stream>>>(x, M, T, norm1, MODX, 6 * DM, 0, DM, XN);
    k_norm_mod<<<MC / 4, 256, 0, stream>>>(ctx, MC, MC, norm1, MODC, 0, 0, DM, XN + (size_t)M * DM);
    EpiIn ein{KA, VA, GK, GV, QA, GQ, GO, GA, GG};
    k_gemm_simple<EpiIn><<<dim3(NIN / 64, M / 64), 256, 0, stream>>>(XN, WinT, DM, 0, ein);
    k_gemm_simple<EpiIn><<<dim3(2048 / 64, MC / 64), 256, 0, stream>>>(XN + (size_t)M * DM, WinT, DM, M, ein);
    k_gemm_simple<EpiLR><<<dim3(1, MALL / 64), 256, 0, stream>>>(XN, WinT + (size_t)6656 * DM, DM, 0, EpiLR{LR});
    k_qknorm_rope<<<(M * 8) / 4, 256, 0, stream>>>(QA, M, 8, 1024, q_norm, ROPE, 0);
    k_qknorm_rope<<<(NB * P * 2) / 4, 256, 0, stream>>>(KA, NB * P, 2, 256, k_norm, ROPE, 1);
    k_attn_naive<<<(M * 8) / 4, 256, 0, stream>>>(QA, KA, VA);
    k_gla_scan_naive<<<16, 1024, 0, stream>>>(GK, GV, GQ, LR, w_gk_f, b_gk_f, OF, 0);
    k_gla_scan_naive<<<16, 1024, 0, stream>>>(GK, GV, GQ, LR, w_gk_b, b_gk_b, OF, 1);
    k_gla_out_naive<<<(M * 4) / 4, 256, 0, stream>>>(OF, GO, gla_norm);
    k_gemm_simple<EpiMerge1><<<dim3(DM / 64, M / 64), 256, 0, stream>>>(QA, WaT, DM, 0, EpiMerge1{GA, Y});
    k_gemm_simple<EpiMerge2><<<dim3(DM / 64, M / 64), 256, 0, stream>>>(GO, WgT, DM, 0, EpiMerge2{GG, Y});
    k_gemm_simple<EpiRes><<<dim3(DM / 64, M / 64), 256, 0, stream>>>(Y, WoT, DM, 0, EpiRes{x, out, MODX, 2 * DM});
    k_norm_mod<<<M / 4, 256, 0, stream>>>(out, M, T, norm2, MODX, 6 * DM, 3 * DM, 4 * DM, HN);
    k_gemm_simple<EpiMlp1><<<dim3(FF / 64, M / 64), 256, 0, stream>>>(HN, W1T, DM, 0, EpiMlp1{H});
    k_gemm_simple<EpiRes><<<dim3(DM / 64, M / 64), 256, 0, stream>>>(H, W2T, FF, 0, EpiRes{out, out, MODX, 5 * DM});
}
```

```cpp
#include <hip/hip_runtime.h>
#include <cstdio>
#include <cstdint>

constexpr int NB = 4, T = 4096, DM = 1024, CTX = 256, P = CTX + T  ;
constexpr int M = NB * T, MC = NB * CTX, MALL = M + MC;
constexpr int NIN = 6656;
constexpr int FF = 4096;
constexpr int NCH = P / 64;
constexpr float EPS = 1e-6f;
constexpr float QSCALE = 0.08838834764831845f;

constexpr size_t MiB = 1u << 20;
constexpr size_t WS_CTL = 0, CTL_ZERO_BYTES = 1 * MiB;
constexpr size_t WS_MODX = 1 * MiB, WS_MODC = 1 * MiB + 128 * 1024, WS_ROPE = 1 * MiB + 192 * 1024;
constexpr size_t WS_GAM = 2 * MiB;
constexpr size_t WS_WIN = 4 * MiB, WS_WA = 18 * MiB, WS_WG = 20 * MiB, WS_WO = 22 * MiB, WS_W1 = 24 * MiB, WS_W2 = 32 * MiB;
constexpr size_t WS_QEB = 24 * MiB;
constexpr size_t WS_KA = 40 * MiB, WS_VA = WS_KA + (size_t)NB * P * 256 * 2, WS_GK = 57 * MiB, WS_GV = 74 * MiB, WS_LR = 108 * MiB;
constexpr size_t WS_QA = 111 * MiB, WS_GQ = 143 * MiB, WS_GO = 159 * MiB, WS_GA = 191 * MiB, WS_GG = 223 * MiB;
constexpr size_t WS_Y = 74 * MiB, WS_HN = 191 * MiB, WS_H = 40 * MiB;
static_assert(WS_VA + (size_t)NB * P * 256 * 2 <= WS_GK, "map");
constexpr size_t DO_OI = 0, DO_KDB = 32 * MiB, DO_AM = 49 * MiB;

typedef unsigned short bf16_t;
typedef short bf16x8 __attribute__((ext_vector_type(8)));
typedef float f32x4 __attribute__((ext_vector_type(4)));
typedef float f32x16 __attribute__((ext_vector_type(16)));
typedef unsigned u32x4 __attribute__((ext_vector_type(4)));
typedef unsigned u32x2 __attribute__((ext_vector_type(2)));

__device__ __forceinline__ unsigned f2bf(float f) { unsigned u = __builtin_bit_cast(unsigned, f); return (u + 0x7fffu + ((u >> 16) & 1u)) >> 16; }
__device__ __forceinline__ float bf2f(bf16_t h) { return __builtin_bit_cast(float, (unsigned)h << 16); }
__device__ __forceinline__ float bflo(unsigned w) { return __builtin_bit_cast(float, w << 16); }
__device__ __forceinline__ float bfhi(unsigned w) { return __builtin_bit_cast(float, w & 0xffff0000u); }
__device__ __forceinline__ float wave_sum(float v) {
#pragma unroll
    for (int o = 1; o < 64; o <<= 1) v += __shfl_xor(v, o);
    return v;
}
__device__ __forceinline__ float sigmoidf_(float x) { return __builtin_amdgcn_rcpf(1.f + __builtin_amdgcn_exp2f(-1.4426950408889634f * x)); }
__device__ __forceinline__ size_t prow(int m) {
    if (m < M) { const int b = m >> 12, t = m & 4095; return (size_t)b * P + CTX + t; }
    const int mc = m - M; const int b = mc >> 8, s = mc & 255; return (size_t)b * P + s;
}
__device__ __forceinline__ int crow(int r, int hi) { return (r & 3) + 8 * (r >> 2) + 4 * hi; }
__device__ __forceinline__ int win_src_col(int nd) {
    if (nd < 2048) return nd;
    if (nd < 6656) return nd + 32;
    if (nd < 6688) return 2048 + (nd - 6656);
    return -1;
}
namespace pg8 {
#define PG8_LAS __attribute__((address_space(3)))
typedef unsigned short bf16_t;
typedef short bf16x8 __attribute__((ext_vector_type(8)));
typedef float f32x4 __attribute__((ext_vector_type(4)));
typedef unsigned u32x4 __attribute__((ext_vector_type(4)));
constexpr int BM = 256, BK = 64, HALF = 128, HTB = HALF * BK * 2  , STAGE_BYTES = 8 * HTB, NXCD = 8, WGM = 8;

__host__ __device__ __forceinline__ int lds_byte(int r, int c) { const int st = (r >> 4) * 2 + (c >> 5), rr = r & 15, cc = c & 31, ob = rr * 64 + cc * 2; return st * 1024 + (ob ^ (((ob >> 9) & 1) << 5)); }
__host__ __device__ __forceinline__ void stage_rc(int b, int& R, int& C) { const int st = b / 1024, sb = b % 1024, swz = sb ^ (((sb >> 9) & 1) << 5); R = (st >> 1) * 16 + swz / 64; C = (st & 1) * 32 + (swz % 64) / 2; }
__host__ __device__ __forceinline__ int perm32(int rho) { const int n = rho >> 4, i = rho & 15; return 8 * (i >> 2) + 4 * n + (i & 3); }

struct Unit { int pm, pn; };
struct Gemm { const bf16_t* A; const bf16_t* Bt; int M, N, K; };

struct StaticOrder {
    int nM, nN, nwg, G, c;
    __host__ __device__ void init(int M, int N, int G_, int c_) { nM = M / BM; nN = N / BM; nwg = nM * nN; G = G_; c = c_; }
    __host__ __device__ bool next(int i, Unit& u) const {
        const long L = (long)i * G + c; if (L >= nwg) return false;
        int wgid = (int)L; { const int q = nwg / NXCD, r = nwg % NXCD, xcd = wgid % NXCD, off = wgid / NXCD; wgid = (xcd < r ? xcd * (q + 1) : r * (q + 1) + (xcd - r) * q) + off; }
        const int nig = WGM * nN, gid = wgid / nig, fm = gid * WGM, gsz = (nM - fm) < WGM ? (nM - fm) : WGM;
        u.pm = fm + ((wgid % nig) % gsz); u.pn = (wgid % nig) / gsz; return true;
    }
    __device__ __forceinline__ void a_ready(const Unit&) const {}
    __device__ __forceinline__ void done(const Unit&) const {}
};

__device__ __forceinline__ unsigned cvt_pk_bf16(float lo, float hi) { unsigned r; asm volatile("v_cvt_pk_bf16_f32 %0, %1, %2" : "=v"(r) : "v"(lo), "v"(hi)); return r; }
typedef float f32x2 __attribute__((ext_vector_type(2)));

__device__ __forceinline__ float sigm(float x) { return __builtin_amdgcn_rcpf(1.f + __builtin_amdgcn_exp2f(-1.4426950408889634f * x)); }
__device__ __forceinline__ float lo16(unsigned w) { return __builtin_bit_cast(float, w << 16); }
__device__ __forceinline__ float hi16(unsigned w) { return __builtin_bit_cast(float, w & 0xffff0000u); }
struct EpiInProj {
    static constexpr bool PERM = true, AFTER_DRAIN = false;
    bf16_t *KA, *VA, *GK, *GV, *QA, *GQ, *GO, *GA, *GG;
    __device__ __forceinline__ void operator()(const f32x4 (&acc)[2][2][4][2], const Unit& u, int wr, int wc, int fr, int fq) const {
        const int pn = u.pn; bf16_t* base; int ldc, colt; float sc = 1.f;
        size_t rowbase;
        if (u.pm < 64) { rowbase = pn < 8 ? (size_t)(u.pm >> 4) * 4352 + 256 + (size_t)(u.pm & 15) * 256 : (size_t)u.pm * 256; }
        else rowbase = (size_t)(u.pm - 64) * 4352;
        if (pn == 0) { base = KA; ldc = 256; colt = 0; }
        else if (pn == 1) { base = VA; ldc = 256; colt = 0; }
        else if (pn < 4) { base = GK; ldc = 512; colt = (pn - 2) * 256; }
        else if (pn < 8) { base = GV; ldc = 1024; colt = (pn - 4) * 256; }
        else if (pn < 12) { base = QA; ldc = 1024; colt = (pn - 8) * 256; }
        else if (pn < 14) { base = GQ; ldc = 512; colt = (pn - 12) * 256; sc = 0.08838834764831845f; }
        else if (pn < 18) { base = GO; ldc = 1024; colt = (pn - 14) * 256; }
        else if (pn < 22) { base = GA; ldc = 1024; colt = (pn - 18) * 256; }
        else { base = GG; ldc = 1024; colt = (pn - 22) * 256; }
        const int col0 = colt + wc * 32 + 8 * fq;
#pragma unroll
        for (int ai = 0; ai < 2; ++ai)
#pragma unroll
            for (int m = 0; m < 4; ++m) { bf16_t* rowp = base + (rowbase + (size_t)(ai * HALF + wr * 64 + m * 16 + fr)) * ldc + col0;
#pragma unroll
                for (int bj = 0; bj < 2; ++bj) { const f32x4 v0 = acc[ai][bj][m][0] * sc, v1 = acc[ai][bj][m][1] * sc;
                    u32x4 w; w.x = cvt_pk_bf16(v0[0], v0[1]); w.y = cvt_pk_bf16(v0[2], v0[3]); w.z = cvt_pk_bf16(v1[0], v1[1]); w.w = cvt_pk_bf16(v1[2], v1[3]);
                    *(u32x4*)(rowp + bj * HALF) = w; } }
    }
};
template <bool FIRST> struct EpiMerge {
    static constexpr bool PERM = true, AFTER_DRAIN = false;
    const bf16_t* G; bf16_t* Y;
    __device__ __forceinline__ void operator()(const f32x4 (&acc)[2][2][4][2], const Unit& u, int wr, int wc, int fr, int fq) const {
        const int row0 = u.pm * BM + wr * 64 + fr, col0 = u.pn * BM + wc * 32 + 8 * fq;
#pragma unroll
        for (int ai = 0; ai < 2; ++ai)
#pragma unroll
            for (int m = 0; m < 4; ++m) { const size_t off = (size_t)(row0 + ai * HALF + m * 16) * 1024 + col0;
#pragma unroll
                for (int bj = 0; bj < 2; ++bj) { const u32x4 g = *(const u32x4*)(G + off + bj * HALF);
                    f32x4 v0 = acc[ai][bj][m][0], v1 = acc[ai][bj][m][1];
                    v0[0] *= sigm(lo16(g.x)); v0[1] *= sigm(hi16(g.x)); v0[2] *= sigm(lo16(g.y)); v0[3] *= sigm(hi16(g.y));
                    v1[0] *= sigm(lo16(g.z)); v1[1] *= sigm(hi16(g.z)); v1[2] *= sigm(lo16(g.w)); v1[3] *= sigm(hi16(g.w));
                    if (!FIRST) { const u32x4 y = *(const u32x4*)(Y + off + bj * HALF);
                        v0[0] += lo16(y.x); v0[1] += hi16(y.x); v0[2] += lo16(y.y); v0[3] += hi16(y.y); v1[0] += lo16(y.z); v1[1] += hi16(y.z); v1[2] += lo16(y.w); v1[3] += hi16(y.w); }
                    u32x4 w; w.x = cvt_pk_bf16(v0[0], v0[1]); w.y = cvt_pk_bf16(v0[2], v0[3]); w.z = cvt_pk_bf16(v1[0], v1[1]); w.w = cvt_pk_bf16(v1[2], v1[3]);
                    *(u32x4*)(Y + off + bj * HALF) = w; } }
    }
};
struct EpiGateRes {
    static constexpr bool PERM = false, AFTER_DRAIN = false;
    const float* base; float* out; const float* gate;
    __device__ __forceinline__ void operator()(const f32x4 (&acc)[2][2][4][2], const Unit& u, int wr, int wc, int fr, int fq) const {
        const int row0 = u.pm * BM + wr * 64 + fr, col0 = u.pn * BM + wc * 32 + 4 * fq;
        const float* gp = gate + (size_t)(u.pm >> 4) * 6144 + col0;
        f32x4 gv[2][2];
#pragma unroll
        for (int bj = 0; bj < 2; ++bj)
#pragma unroll
            for (int n = 0; n < 2; ++n) gv[bj][n] = *(const f32x4*)(gp + bj * HALF + n * 16);
#pragma unroll
        for (int ai = 0; ai < 2; ++ai)
#pragma unroll
            for (int m = 0; m < 4; ++m) { const size_t off = (size_t)(row0 + ai * HALF + m * 16) * 1024 + col0;
#pragma unroll
                for (int bj = 0; bj < 2; ++bj)
#pragma unroll
                    for (int n = 0; n < 2; ++n) { const f32x4 b = *(const f32x4*)(base + off + bj * HALF + n * 16);
                        *(f32x4*)(out + off + bj * HALF + n * 16) = b + gv[bj][n] * acc[ai][bj][m][n]; } }
    }
};
struct EpiSqRelu {
    static constexpr bool PERM = true, AFTER_DRAIN = false;
    bf16_t* H;
    __device__ __forceinline__ void operator()(const f32x4 (&acc)[2][2][4][2], const Unit& u, int wr, int wc, int fr, int fq) const {
        const int row0 = u.pm * BM + wr * 64 + fr, col0 = u.pn * BM + wc * 32 + 8 * fq;
#pragma unroll
        for (int ai = 0; ai < 2; ++ai)
#pragma unroll
            for (int m = 0; m < 4; ++m) { bf16_t* rowp = H + (size_t)(row0 + ai * HALF + m * 16) * 4096 + col0;
#pragma unroll
                for (int bj = 0; bj < 2; ++bj) { f32x4 v0 = acc[ai][bj][m][0], v1 = acc[ai][bj][m][1];
#pragma unroll
                    for (int e = 0; e < 4; ++e) { const float a = __builtin_fmaxf(v0[e], 0.f), b = __builtin_fmaxf(v1[e], 0.f); v0[e] = a * a; v1[e] = b * b; }
                    u32x4 w; w.x = cvt_pk_bf16(v0[0], v0[1]); w.y = cvt_pk_bf16(v0[2], v0[3]); w.z = cvt_pk_bf16(v1[0], v1[1]); w.w = cvt_pk_bf16(v1[2], v1[3]);
                    *(u32x4*)(rowp + bj * HALF) = w; } }
    }
};
struct InOrder {
    StaticOrder so;
    __device__ void init(int G_, int c_) { so.init(16384, 6656, G_, c_); }
    __device__ bool next(int i, Unit& u) const {
        const int L = i * so.G + so.c; if (L >= 1696) return false;
        if (L < 1664) return so.next(i, u);
        const int e = L - 1664; u.pm = 64 + (e >> 3); u.pn = e & 7; return true;
    }
    __device__ __forceinline__ void a_ready(const Unit&) const {}
    __device__ __forceinline__ void done(const Unit&) const {}
};

template <class Epi, class Sched, bool ALIGN_EPI = false, bool SP2 = false>
__device__ __forceinline__ void gemm_phase(PG8_LAS unsigned char* lds, const Gemm g, const Sched& S, const Epi& E) {
    const int tid = threadIdx.x, wid = __builtin_amdgcn_readfirstlane(tid >> 6), lane = tid & 63, wr = wid >> 2, wc = wid & 3, fr = lane & 15, fq = lane >> 4;
    const int K = g.K, nt = K / BK;
    unsigned voffA[2], voffB[2];
#pragma unroll
    for (int i = 0; i < 2; ++i) { int R, C; stage_rc(tid * 16 + i * 8192, R, C); const int Rb = Epi::PERM ? ((R & ~31) + perm32(R & 31)) : R;
        voffA[i] = (unsigned)(R * K + C) * 2u; voffB[i] = (unsigned)(Rb * K + C) * 2u; }
    const size_t kstep = (size_t)(BK * 2);
    const size_t hstep = (size_t)HALF * K * 2;
    const size_t tstep = 2 * hstep;
    const unsigned ldsw = (unsigned)wid * 1024u;
    const int aoff = lds_byte(wr * 64 + fr, fq * 8), boff = lds_byte(wc * 32 + fr, fq * 8);
#define PG8_SA(b, h) (((b) * 2 + (h)) * HTB)
#define PG8_SB(b, h) ((4 + (b) * 2 + (h)) * HTB)
#define PG8_STAGE(bufoff, gbase, voff) do { _Pragma("unroll") for (int _i = 0; _i < 2; ++_i) \
        __builtin_amdgcn_global_load_lds((const unsigned*)((const char*)(gbase) + (voff)[_i]), (PG8_LAS unsigned*)(lds + (bufoff) + ldsw + _i * 8192), 16, 0, 0); } while (0)
#define PG8_LDA(dst, b, h) do { _Pragma("unroll") for (int m = 0; m < 4; ++m) _Pragma("unroll") for (int k = 0; k < 2; ++k) dst[m][k] = *(const PG8_LAS bf16x8*)(lds + PG8_SA(b, h) + aoff + m * 2048 + k * 1024); } while (0)
#define PG8_LDB(dst, b, h) do { _Pragma("unroll") for (int n = 0; n < 2; ++n) _Pragma("unroll") for (int k = 0; k < 2; ++k) dst[n][k] = *(const PG8_LAS bf16x8*)(lds + PG8_SB(b, h) + boff + n * 2048 + k * 1024); } while (0)
#define PG8_MMA(ai, bj, At, Bt) do { __builtin_amdgcn_s_setprio(1); _Pragma("unroll") for (int m = 0; m < 4; ++m) _Pragma("unroll") for (int n = 0; n < 2; ++n) _Pragma("unroll") for (int k = 0; k < 2; ++k) \
        acc[ai][bj][m][n] = __builtin_amdgcn_mfma_f32_16x16x32_bf16(Bt[n][k], At[m][k], acc[ai][bj][m][n], 0, 0, 0); __builtin_amdgcn_s_setprio(0); } while (0)
#define PG8_WAIT_V(n) asm volatile("s_waitcnt vmcnt(" #n ")" ::: "memory")
#define PG8_WAIT_L(n) asm volatile("s_waitcnt lgkmcnt(" #n ")" ::: "memory")
#define PG8_BAR __builtin_amdgcn_s_barrier()
#define PG8_SCHED __builtin_amdgcn_sched_barrier(0)
    Unit cur, nxt; int ui = 0;
    if (!S.next(0, cur)) return;
    f32x4 acc[2][2][4][2];
#pragma unroll
    for (int a = 0; a < 2; ++a)
#pragma unroll
        for (int b = 0; b < 2; ++b)
#pragma unroll
            for (int m = 0; m < 4; ++m)
#pragma unroll
                for (int n = 0; n < 2; ++n) acc[a][b][m][n] = (f32x4){0.f, 0.f, 0.f, 0.f};
    bf16x8 At[4][2], B0[2][2], B1[2][2];
    const char* cA = (const char*)g.A + (size_t)cur.pm * tstep; const char* cB = (const char*)g.Bt + (size_t)cur.pn * tstep;
    S.a_ready(cur);
    if constexpr (SP2) {
        PG8_STAGE(PG8_SB(0, 0), cB, voffB); PG8_STAGE(PG8_SB(0, 1), cB + hstep, voffB); PG8_STAGE(PG8_SA(0, 0), cA, voffA); PG8_STAGE(PG8_SA(0, 1), cA + hstep, voffA);
        if (wr == 1) PG8_BAR;
        PG8_WAIT_V(2); PG8_BAR;
        PG8_STAGE(PG8_SB(1, 0), cB + kstep, voffB); PG8_STAGE(PG8_SA(1, 0), cA + kstep, voffA); PG8_STAGE(PG8_SB(1, 1), cB + hstep + kstep, voffB);
        PG8_WAIT_V(6); PG8_BAR;
    } else {
        PG8_STAGE(PG8_SB(0, 0), cB, voffB); PG8_STAGE(PG8_SA(0, 0), cA, voffA); PG8_STAGE(PG8_SB(0, 1), cB + hstep, voffB); PG8_STAGE(PG8_SA(0, 1), cA + hstep, voffA);
        if (wr == 1) PG8_BAR;
        PG8_WAIT_V(4); PG8_BAR;
        PG8_STAGE(PG8_SB(1, 0), cB + kstep, voffB); PG8_STAGE(PG8_SA(1, 0), cA + kstep, voffA); PG8_STAGE(PG8_SB(1, 1), cB + hstep + kstep, voffB);
        PG8_WAIT_V(6); PG8_BAR;
    }
    for (;;) {
        const bool has_next = S.next(ui + 1, nxt);
        const char* nA = has_next ? (const char*)g.A + (size_t)nxt.pm * tstep : cA; const char* nB = has_next ? (const char*)g.Bt + (size_t)nxt.pn * tstep : cB;
        for (int t = 0; t < nt; t += 2) {
            const bool last = (t == nt - 2);
            const char* a1 = cA + (size_t)(t + 1) * kstep;
            const char* a2 = last ? nA : cA + (size_t)(t + 2) * kstep; const char* b2 = last ? nB : cB + (size_t)(t + 2) * kstep;
            const char* a3 = a2 + kstep; const char* b3 = b2 + kstep;
            if (last && has_next) S.a_ready(nxt);
            if constexpr (SP2) {
            PG8_LDB(B0, 0, 0); PG8_LDB(B1, 0, 1); PG8_SCHED; PG8_LDA(At, 0, 0); PG8_STAGE(PG8_SA(1, 1), a1 + hstep, voffA);
            PG8_WAIT_V(8); PG8_WAIT_L(0); PG8_BAR; PG8_MMA(0, 0, At, B0); PG8_MMA(0, 1, At, B1); PG8_BAR; PG8_SCHED;
            PG8_LDA(At, 0, 1); PG8_STAGE(PG8_SB(0, 0), b2, voffB); PG8_STAGE(PG8_SB(0, 1), b2 + hstep, voffB); PG8_STAGE(PG8_SA(0, 0), a2, voffA);
            PG8_WAIT_V(8); PG8_WAIT_L(0); PG8_BAR; PG8_MMA(1, 0, At, B0); PG8_MMA(1, 1, At, B1); PG8_BAR; PG8_SCHED;
            PG8_LDB(B0, 1, 0); PG8_LDB(B1, 1, 1); PG8_SCHED; PG8_LDA(At, 1, 0); PG8_STAGE(PG8_SA(0, 1), a2 + hstep, voffA);
            PG8_WAIT_V(8); PG8_WAIT_L(0); PG8_BAR; PG8_MMA(0, 0, At, B0); PG8_MMA(0, 1, At, B1); PG8_BAR; PG8_SCHED;
            PG8_LDA(At, 1, 1); PG8_STAGE(PG8_SB(1, 0), b3, voffB); PG8_STAGE(PG8_SB(1, 1), b3 + hstep, voffB); PG8_STAGE(PG8_SA(1, 0), a3, voffA);
            PG8_WAIT_V(8); PG8_WAIT_L(0); PG8_BAR; PG8_MMA(1, 0, At, B0); PG8_MMA(1, 1, At, B1); PG8_BAR; PG8_SCHED;
            } else {
            PG8_LDB(B0, 0, 0); PG8_SCHED; PG8_LDA(At, 0, 0); PG8_STAGE(PG8_SA(1, 1), a1 + hstep, voffA);
            PG8_WAIT_L(8); PG8_BAR; PG8_WAIT_L(0); PG8_MMA(0, 0, At, B0); PG8_BAR; PG8_SCHED;
            PG8_LDB(B1, 0, 1); PG8_STAGE(PG8_SB(0, 0), b2, voffB);
            PG8_BAR; PG8_WAIT_L(0); PG8_MMA(0, 1, At, B1); PG8_BAR;
            PG8_LDA(At, 0, 1); PG8_STAGE(PG8_SA(0, 0), a2, voffA);
            PG8_BAR; PG8_WAIT_L(0); PG8_MMA(1, 0, At, B0); PG8_BAR; PG8_SCHED;
            PG8_STAGE(PG8_SB(0, 1), b2 + hstep, voffB);
            PG8_WAIT_V(6); PG8_BAR; PG8_MMA(1, 1, At, B1); PG8_BAR;
            PG8_LDB(B0, 1, 0); PG8_SCHED; PG8_LDA(At, 1, 0); PG8_STAGE(PG8_SA(0, 1), a2 + hstep, voffA);
            PG8_WAIT_L(8); PG8_BAR; PG8_WAIT_L(0); PG8_MMA(0, 0, At, B0); PG8_BAR; PG8_SCHED;
            PG8_LDB(B1, 1, 1); PG8_STAGE(PG8_SB(1, 0), b3, voffB);
            PG8_BAR; PG8_WAIT_L(0); PG8_MMA(0, 1, At, B1); PG8_BAR;
            PG8_LDA(At, 1, 1); PG8_STAGE(PG8_SA(1, 0), a3, voffA);
            PG8_BAR; PG8_WAIT_L(0); PG8_MMA(1, 0, At, B0); PG8_BAR; PG8_SCHED;
            PG8_STAGE(PG8_SB(1, 1), b3 + hstep, voffB);
            PG8_WAIT_V(6); PG8_BAR; PG8_MMA(1, 1, At, B1); PG8_BAR;
            }
        }
        if constexpr (ALIGN_EPI) { if (wr == 0) PG8_BAR; }
        if constexpr (!Epi::AFTER_DRAIN) { E(acc, cur, wr, wc, fr, fq); S.done(cur); }
        if (!has_next) break;
#pragma unroll
        for (int a = 0; a < 2; ++a)
#pragma unroll
            for (int b = 0; b < 2; ++b)
#pragma unroll
                for (int m = 0; m < 4; ++m)
#pragma unroll
                    for (int n = 0; n < 2; ++n) acc[a][b][m][n] = (f32x4){0.f, 0.f, 0.f, 0.f};
        cur = nxt; cA = nA; cB = nB; ++ui;
        if constexpr (ALIGN_EPI) { if (wr == 1) PG8_BAR; }
    }
    PG8_WAIT_V(0);
    if constexpr (!ALIGN_EPI) { if (wr == 0) PG8_BAR; }
    PG8_BAR;
    if constexpr (Epi::AFTER_DRAIN) { E.fused(acc, cur, wr, wc, fr, fq, lds, wid, lane); S.done(cur); }
#undef PG8_SA
#undef PG8_SB
#undef PG8_STAGE
#undef PG8_LDA
#undef PG8_LDB
#undef PG8_MMA
#undef PG8_WAIT_V
#undef PG8_WAIT_L
#undef PG8_BAR
#undef PG8_SCHED
}
}
#define GAS __attribute__((address_space(1)))
#define LAS __attribute__((address_space(3)))
typedef unsigned short bf16;
typedef unsigned v4u __attribute__((ext_vector_type(4)));
typedef float f32x4 __attribute__((ext_vector_type(4)));
typedef short bf16x8 __attribute__((ext_vector_type(8)));
typedef GAS unsigned gu32;
typedef GAS unsigned long long gu64;
#define RLX_AGENT __ATOMIC_RELAXED, __HIP_MEMORY_SCOPE_AGENT
#define LDS_WAIT() asm volatile("s_waitcnt lgkmcnt(0)" ::: "memory")
#define VM_WAIT() asm volatile("s_waitcnt vmcnt(0)" ::: "memory")
__device__ __forceinline__ unsigned long long rt() { return __builtin_amdgcn_s_memrealtime(); }
__device__ __forceinline__ unsigned pk2(float lo, float hi) { return f2bf(lo) | (f2bf(hi) << 16); }

#define XB_TMO      128
#define XB_XCNT(j)  (256  + 64 * (j))
#define XB_XSUB(j)  (1280 + 64 * (j))
#define XB_XGEN(j)  (2304 + 64 * (j))
#define XB_TOP      3328
#define XB_TOPGEN   3392
#define XCD_BAR_WORDS 3456
#define XB_SPIN_CAP (1u << 18)

__device__ __forceinline__ unsigned xb_ld(unsigned* p)              { return __hip_atomic_load(p, __ATOMIC_RELAXED, __HIP_MEMORY_SCOPE_AGENT); }
__device__ __forceinline__ unsigned xb_add(unsigned* p, unsigned v) { return __hip_atomic_fetch_add(p, v, __ATOMIC_RELAXED, __HIP_MEMORY_SCOPE_AGENT); }
__device__ __forceinline__ unsigned xb_xcc_id() { return (unsigned)__builtin_amdgcn_s_getreg((3 << 11) | 20) & 0xFu; }
#define XB_SPIN(cond, bar) do { unsigned _sp = 0; while (cond) { __builtin_amdgcn_s_sleep(1); \
    if ((++_sp & 255u) == 0u) { if (xb_ld(&(bar)[XB_TMO])) break; if (_sp > XB_SPIN_CAP) { atomicAdd(&(bar)[XB_TMO], 1u); break; } } } } while (0)

struct XcdBarrier {
    unsigned* bar; unsigned x;
    volatile LAS unsigned* st;
};

__device__ __forceinline__ XcdBarrier xcd_barrier_post(unsigned* bar, volatile LAS unsigned* st) {
    XcdBarrier b; b.bar = bar; b.x = xb_xcc_id(); b.st = st;
    if (threadIdx.x == 0) (void)xb_add(&bar[XB_XCNT(b.x)], 1u);
    return b;
}
__device__ __forceinline__ void xcd_barrier_complete(unsigned* bar, unsigned x, unsigned& nloc, unsigned& nx) {
    const unsigned G = gridDim.x * gridDim.y * gridDim.z;
    unsigned sum, cnt, mine, sp = 0u;
    for (;;) {
        sum = 0u; cnt = 0u; mine = 0u;
#pragma unroll
        for (unsigned j = 0; j < 16; ++j) { const unsigned c = xb_ld(&bar[XB_XCNT(j)]); sum += c; cnt += (c > 0u) ? 1u : 0u; mine = (j == x) ? c : mine; }
        if (sum == G) break;
        __builtin_amdgcn_s_sleep(1);
        if ((++sp & 255u) == 0u) { if (xb_ld(&bar[XB_TMO])) break; if (sp > XB_SPIN_CAP) { atomicAdd(&bar[XB_TMO], 1u); break; } }
    }
    nloc = mine > 0u ? mine : 1u; nx = cnt > 0u ? cnt : 1u;
}

__device__ __forceinline__ void xcd_barrier(const XcdBarrier& b) {
    asm volatile("s_waitcnt vmcnt(0)" ::: "memory");
    __syncthreads();
    if (threadIdx.x == 0) {
        unsigned* bar = b.bar;
        __builtin_amdgcn_s_waitcnt(0);
        unsigned nloc = b.st[0], nx = b.st[1];
        if (nloc == 0u) { xcd_barrier_complete(bar, b.x, nloc, nx); b.st[0] = nloc; b.st[1] = nx; }
        const unsigned old = xb_add(&bar[XB_XSUB(b.x)], 1u);
        const unsigned gen = old / nloc;
        if (old + 1u == (gen + 1u) * nloc) {
            __builtin_amdgcn_fence(__ATOMIC_RELEASE, "agent");
            asm volatile("s_waitcnt vmcnt(0)" ::: "memory");
            const unsigned og = xb_add(&bar[XB_TOP], 1u);
            const unsigned tg = og / nx;
            if (og + 1u == (tg + 1u) * nx) xb_add(&bar[XB_TOPGEN], 1u);
            else XB_SPIN(xb_ld(&bar[XB_TOPGEN]) == tg, bar);
            __builtin_amdgcn_fence(__ATOMIC_ACQUIRE, "agent");
            xb_add(&bar[XB_XGEN(b.x)], 1u);
            asm volatile("s_waitcnt vmcnt(0)" ::: "memory");
        } else {
            XB_SPIN(xb_ld(&bar[XB_XGEN(b.x)]) == gen, bar);
            __builtin_amdgcn_fence(__ATOMIC_ACQUIRE, "agent");
            asm volatile("s_waitcnt vmcnt(0)" ::: "memory");
        }
    }
    __syncthreads();
}

__global__ void k_convT(const float* __restrict__ W, int K, int N, bf16_t* __restrict__ out, int ndst, int mode) {
    const size_t idx = (size_t)blockIdx.x * 256 + threadIdx.x;
    if (idx >= (size_t)ndst * K) return;
    const int nd = (int)(idx % ndst), k = (int)(idx / ndst);
    const int ns = mode ? win_src_col(nd) : nd;
    const float v = ns >= 0 ? W[(size_t)k * N + ns] : 0.f;
    out[(size_t)nd * K + k] = (bf16_t)f2bf(v);
}
__global__ void k_adaln(const float* __restrict__ c, const float* __restrict__ c_ctx, const float* __restrict__ w_ada, const float* __restrict__ b_ada,
                        float* __restrict__ modx, float* __restrict__ modc) {
    const int j = blockIdx.x * 256 + threadIdx.x, r = blockIdx.y;
    if (j >= 6 * DM) return;
    if (r == 4 && j >= 2 * DM) return;
    const float* cv = r < 4 ? c + r * DM : c_ctx;
    float acc = 0.f;
    for (int k = 0; k < DM; ++k) { const float x = cv[k]; acc += (x / (1.f + expf(-x))) * w_ada[(size_t)k * 6 * DM + j]; }
    acc += b_ada[j];
    if (r < 4) modx[r * 6 * DM + j] = acc; else modc[j] = acc;
}
__global__ void k_rope_table(float* __restrict__ rope) {
    const int i = blockIdx.x * 256 + threadIdx.x; if (i >= 64 * 32) return;
    const int pos = i >> 5, f = i & 31;
    const float freq = powf(10000.f, -(float)(2 * f) / 64.f);
    const float ang = (float)pos * freq;
    rope[2 * i] = cosf(ang); rope[2 * i + 1] = sinf(ang);
}
__global__ void k_norm_mod(const float* __restrict__ X, int nrows, int rows_per_batch, const float* __restrict__ gw,
                           const float* __restrict__ mod, int mod_bstride, int sh_off, int sc_off, bf16_t* __restrict__ out) {
    const int row = blockIdx.x * 4 + (threadIdx.x >> 6), lane = threadIdx.x & 63;
    if (row >= nrows) return;
    const int b = row / rows_per_batch;
    const float* xr = X + (size_t)row * DM; const float* sh = mod + (size_t)b * mod_bstride + sh_off; const float* sc = mod + (size_t)b * mod_bstride + sc_off;
    float v[16]; float s = 0.f;
#pragma unroll
    for (int i = 0; i < 16; ++i) { v[i] = xr[lane + 64 * i]; s += v[i] * v[i]; }
    const float r = rsqrtf(wave_sum(s) * (1.f / DM) + EPS);
#pragma unroll
    for (int i = 0; i < 16; ++i) { const int k = lane + 64 * i; const float y = v[i] * r * gw[k]; out[(size_t)row * DM + k] = (bf16_t)f2bf(y * (1.f + sc[k]) + sh[k]); }
}

template <class Epi>
__global__ __launch_bounds__(256) void k_gemm_simple(const bf16_t* __restrict__ A, const bf16_t* __restrict__ Bt, int K, int m_off, Epi epi) {
    const int wave = threadIdx.x >> 6, lane = threadIdx.x & 63, fr = lane & 15, fq = lane >> 4;
    const int m0 = blockIdx.y * 64 + (wave >> 1) * 32, n0 = blockIdx.x * 64 + (wave & 1) * 32;
    f32x4 acc[2][2];
#pragma unroll
    for (int i = 0; i < 2; ++i)
#pragma unroll
        for (int j = 0; j < 2; ++j) acc[i][j] = (f32x4){0.f, 0.f, 0.f, 0.f};
    for (int k0 = 0; k0 < K; k0 += 32) {
        bf16x8 a[2], b[2];
#pragma unroll
        for (int i = 0; i < 2; ++i) a[i] = *(const bf16x8*)(A + (size_t)(m0 + i * 16 + fr) * K + k0 + fq * 8);
#pragma unroll
        for (int j = 0; j < 2; ++j) b[j] = *(const bf16x8*)(Bt + (size_t)(n0 + j * 16 + fr) * K + k0 + fq * 8);
#pragma unroll
        for (int i = 0; i < 2; ++i)
#pragma unroll
            for (int j = 0; j < 2; ++j) acc[i][j] = __builtin_amdgcn_mfma_f32_16x16x32_bf16(a[i], b[j], acc[i][j], 0, 0, 0);
    }
#pragma unroll
    for (int i = 0; i < 2; ++i)
#pragma unroll
        for (int j = 0; j < 2; ++j)
#pragma unroll
            for (int r = 0; r < 4; ++r) epi(m_off + m0 + i * 16 + fq * 4 + r, n0 + j * 16 + fr, acc[i][j][r]);
}
struct EpiIn {
    bf16_t *KA, *VA, *GK, *GV, *QA, *GQ, *GO, *GA, *GG;
    __device__ __forceinline__ void operator()(int m, int n, float v) const {
        const size_t pr = prow(m);
        if (n < 256) { KA[pr * 256 + n] = (bf16_t)f2bf(v); return; }
        if (n < 512) { VA[pr * 256 + (n - 256)] = (bf16_t)f2bf(v); return; }
        if (n < 1024) { GK[pr * 512 + (n - 512)] = (bf16_t)f2bf(v); return; }
        if (n < 2048) { GV[pr * 1024 + (n - 1024)] = (bf16_t)f2bf(v); return; }
        if (m >= M) return;
        if (n < 3072) { QA[(size_t)m * 1024 + (n - 2048)] = (bf16_t)f2bf(v); return; }
        if (n < 3584) { GQ[(size_t)m * 512 + (n - 3072)] = (bf16_t)f2bf(v * 0.08838834764831845f); return; }
        if (n < 4608) { GO[(size_t)m * 1024 + (n - 3584)] = (bf16_t)f2bf(v); return; }
        if (n < 5632) { GA[(size_t)m * 1024 + (n - 4608)] = (bf16_t)f2bf(v); return; }
        GG[(size_t)m * 1024 + (n - 5632)] = (bf16_t)f2bf(v);
    }
};
struct EpiLR { float* LR; __device__ __forceinline__ void operator()(int m, int n, float v) const { if (n < 32) LR[prow(m) * 32 + n] = v; } };
struct EpiMerge1 { const bf16_t* G; bf16_t* Y; __device__ __forceinline__ void operator()(int m, int n, float v) const {
    const size_t i = (size_t)m * 1024 + n; Y[i] = (bf16_t)f2bf(sigmoidf_(bf2f(G[i])) * v); } };
struct EpiMerge2 { const bf16_t* G; bf16_t* Y; __device__ __forceinline__ void operator()(int m, int n, float v) const {
    const size_t i = (size_t)m * 1024 + n; Y[i] = (bf16_t)f2bf(bf2f(Y[i]) + sigmoidf_(bf2f(G[i])) * v); } };
struct EpiRes { const float* base; float* out; const float* modx; int gt_off; __device__ __forceinline__ void operator()(int m, int n, float v) const {
    const size_t i = (size_t)m * 1024 + n; out[i] = base[i] + modx[(m >> 12) * 6 * DM + gt_off + n] * v; } };
struct EpiMlp1 { bf16_t* H; __device__ __forceinline__ void operator()(int m, int n, float v) const { const float r = v > 0.f ? v : 0.f; H[(size_t)m * FF + n] = (bf16_t)f2bf(r * r); } };

__global__ void k_qknorm_rope(bf16_t* __restrict__ buf, int nrows, int nheads, int pitch, const float* __restrict__ gw, const float* __restrict__ rope, int mode) {
    const int wid = blockIdx.x * 4 + (threadIdx.x >> 6), lane = threadIdx.x & 63;
    if (wid >= nrows * nheads) return;
    const int row = wid / nheads, h = wid % nheads;
    bf16_t* p = buf + (size_t)row * pitch + h * 128;
    float v0 = bf2f(p[lane]), v1 = bf2f(p[64 + lane]);
    const float r = rsqrtf(wave_sum(v0 * v0 + v1 * v1) * (1.f / 128.f) + EPS);
    v0 = v0 * r * gw[lane]; v1 = v1 * r * gw[64 + lane];
    int t; bool dorope = true;
    if (mode == 0) t = row & 4095; else { const int pp = row % P; dorope = pp >= CTX; t = pp - CTX; }
    if (dorope) {
        const int prow_ = t >> 6, pcol = t & 63, f = lane & 31, hf = lane >> 5;
        const float c0 = rope[2 * (prow_ * 32 + f)], s0 = rope[2 * (prow_ * 32 + f) + 1];
        const float c1 = rope[2 * (pcol * 32 + f)], s1 = rope[2 * (pcol * 32 + f) + 1];
        const float q0 = __shfl_xor(v0, 32), q1 = __shfl_xor(v1, 32);
        v0 = hf == 0 ? v0 * c0 - q0 * s0 : v0 * c0 + q0 * s0;
        v1 = hf == 0 ? v1 * c1 - q1 * s1 : v1 * c1 + q1 * s1;
    }
    p[lane] = (bf16_t)f2bf(v0); p[64 + lane] = (bf16_t)f2bf(v1);
}

__global__ void k_attn_naive(bf16_t* __restrict__ QA, const bf16_t* __restrict__ KA, const bf16_t* __restrict__ VA) {
    const int wid = blockIdx.x * 4 + (threadIdx.x >> 6), lane = threadIdx.x & 63;
    const int h = wid & 7, m = wid >> 3, b = m >> 12, kvh = h >> 2;
    bf16_t* qp = QA + (size_t)m * 1024 + h * 128 + 2 * lane;
    const float q0 = bf2f(qp[0]), q1 = bf2f(qp[1]);
    const bf16_t* kp = KA + (size_t)b * P * 256 + kvh * 128 + 2 * lane; const bf16_t* vp = VA + (size_t)b * P * 256 + kvh * 128 + 2 * lane;
    float mx = -1e30f, l = 0.f, a0 = 0.f, a1 = 0.f;
    for (int p = 0; p < P; ++p) {
        const unsigned kk = *(const unsigned*)(kp + (size_t)p * 256), vv = *(const unsigned*)(vp + (size_t)p * 256);
        float s = q0 * bf2f((bf16_t)(kk & 0xffff)) + q1 * bf2f((bf16_t)(kk >> 16));
        s = wave_sum(s) * 0.08838834764831845f;
        const float mn = fmaxf(mx, s), al = __expf(mx - mn), pe = __expf(s - mn);
        l = l * al + pe; a0 = a0 * al + pe * bf2f((bf16_t)(vv & 0xffff)); a1 = a1 * al + pe * bf2f((bf16_t)(vv >> 16)); mx = mn;
    }
    const float il = 1.f / l;
    qp[0] = (bf16_t)f2bf(a0 * il); qp[1] = (bf16_t)f2bf(a1 * il);
}

__device__ __forceinline__ float logsigmoidf_(float x) { return fminf(x, 0.f) - log1pf(expf(-fabsf(x))); }
__global__ __launch_bounds__(1024) void k_gla_scan_naive(const bf16_t* __restrict__ GK, const bf16_t* __restrict__ GV, const bf16_t* __restrict__ GQ, const float* __restrict__ LR,
                                                       const float* __restrict__ w_gk, const float* __restrict__ b_gk, float* __restrict__ OF, int dir) {
    __shared__ float eg[128], sk[128], sq[128], sv[256], red[4][256];
    const int bh = blockIdx.x, b = bh >> 2, h = bh & 3, tid = threadIdx.x, dv = tid & 255, dq = tid >> 8;
    float S[32];
#pragma unroll
    for (int i = 0; i < 32; ++i) S[i] = 0.f;
    for (int i = 0; i < P; ++i) {
        int p; if (dir == 0) p = i; else p = i < CTX ? (CTX - 1 - i) : CTX + (T - 1 - (i - CTX));
        const bool isx = p >= CTX; const int m = b * T + (p - CTX);
        const size_t pr = (size_t)b * P + p;
        if (tid < 128) {
            const int d = tid; float xg = b_gk[h * 128 + d];
            for (int r = 0; r < 16; ++r) xg += LR[pr * 32 + dir * 16 + r] * w_gk[r * 512 + h * 128 + d];
            eg[d] = expf(logsigmoidf_(xg) * (1.f / 16.f));
            sk[d] = bf2f(GK[pr * 512 + h * 128 + d]);
            sq[d] = isx ? bf2f(GQ[(size_t)m * 512 + h * 128 + d]) : 0.f;
        } else if (tid < 384) { const int e = tid - 128; sv[e] = bf2f(GV[pr * 1024 + h * 256 + e]); }
        __syncthreads();
        const float v = sv[dv]; float po = 0.f;
#pragma unroll
        for (int j = 0; j < 32; ++j) { const int d = dq * 32 + j; S[j] = eg[d] * S[j] + sk[d] * v; po += sq[d] * S[j]; }
        if (isx) red[dq][dv] = po;
        __syncthreads();
        if (isx && tid < 256) { const float o = (red[0][tid] + red[1][tid]) + (red[2][tid] + red[3][tid]); float* op = OF + (size_t)m * 1024 + h * 256 + tid; if (dir == 0) *op = o; else *op += o; }
    }
}
__global__ void k_gla_out_naive(const float* __restrict__ OF, bf16_t* __restrict__ GO, const float* __restrict__ gn) {
    const int wid = blockIdx.x * 4 + (threadIdx.x >> 6), lane = threadIdx.x & 63;
    const int h = wid & 3, m = wid >> 2;
    const float* op = OF + (size_t)m * 1024 + h * 256; bf16_t* gp = GO + (size_t)m * 1024 + h * 256;
    float v[4]; float s = 0.f;
#pragma unroll
    for (int i = 0; i < 4; ++i) { v[i] = op[lane + 64 * i]; s += v[i] * v[i]; }
    const float r = rsqrtf(wave_sum(s) * (1.f / 256.f) + EPS);
#pragma unroll
    for (int i = 0; i < 4; ++i) { const int e = lane + 64 * i; const float g = bf2f(gp[e]); gp[e] = (bf16_t)f2bf(v[i] * r * gn[e] * (g * sigmoidf_(g))); }
}


namespace att {
using bf16 = unsigned short;
constexpr int   D = 128, NW = 8, QBLK = 32, KVBLK = 64;
constexpr float SCALE = 0.088388347648318440f;
constexpr float THR = 8.f;
constexpr int SDEPTH = 2;
constexpr int LDQ = 1024, LDK = 256, LDO = 1024;
constexpr size_t SHM_V = KVBLK * D * 2, SHM_K = KVBLK * D * 2, SHM_ATTN = 2 * SHM_V + 2 * SHM_K + NW * 64 * 4;
using s16x4  = __attribute__((ext_vector_type(4))) short;
using f32x8  = __attribute__((ext_vector_type(8))) float;
using bf16x8 = __attribute__((ext_vector_type(8))) short;
using s16x4  = __attribute__((ext_vector_type(4))) short;
using f32x16 = __attribute__((ext_vector_type(16))) float;
using f32x8  = __attribute__((ext_vector_type(8))) float;
using u32x4  = __attribute__((ext_vector_type(4))) unsigned;
#define KSWZ(row, colB) ((row) * 256 + ((colB) ^ (((row) & 7) << 4)))
#define SBAR() __builtin_amdgcn_sched_barrier(0)
__device__ __forceinline__ unsigned cvtpk(float lo, float hi) {
  unsigned r; asm volatile("v_cvt_pk_bf16_f32 %0, %1, %2" : "=v"(r) : "v"(lo), "v"(hi)); return r;
}
template <typename TIn> struct Stage;
template <> struct Stage<bf16>  { using T = bf16x8;
  __device__ static __forceinline__ T ld8(const bf16* p) { return *reinterpret_cast<const bf16x8*>(p); }
  __device__ static __forceinline__ bf16x8 tobf(T x) { return x; } };
__device__ __forceinline__ void partialSM(f32x16& p0, f32x16& p1, float& m_reg, float& mn, float& alpha) {
  constexpr float C = SCALE * 1.4426950408889634f;
  float pmax = p0[0]; for (int r = 1; r < 16; ++r) pmax = fmaxf(pmax, p0[r]); for (int r = 0; r < 16; ++r) pmax = fmaxf(pmax, p1[r]);
  { auto rr = __builtin_amdgcn_permlane32_swap(__float_as_uint(pmax), __float_as_uint(pmax), false, false);
    pmax = fmaxf(__uint_as_float(rr[0]), __uint_as_float(rr[1])); }
  if (__builtin_expect(__all(pmax - m_reg <= THR / SCALE), 1)) { mn = m_reg; alpha = 1.f; }
  else { mn = fmaxf(m_reg, pmax); alpha = __builtin_amdgcn_exp2f((m_reg - mn) * C); m_reg = mn; }
  float mnC = -mn * C;
  for (int r = 0; r < 16; ++r) p0[r] = fmaf(p0[r], C, mnC); for (int r = 0; r < 16; ++r) p1[r] = fmaf(p1[r], C, mnC);
  for (int r = 0; r < 16; ++r) p0[r] = __builtin_amdgcn_exp2f(p0[r]);
}
__device__ __forceinline__ void finishSM(f32x16& p0, f32x16& p1, float alpha, float& l_reg, bf16x8& pa0, bf16x8& pa1, bf16x8& pa2, bf16x8& pa3) {
  for (int r = 0; r < 16; ++r) p1[r] = __builtin_amdgcn_exp2f(p1[r]);
  float ps = 0; for (int r = 0; r < 16; ++r) ps += p0[r]; for (int r = 0; r < 16; ++r) ps += p1[r];
  { auto rr = __builtin_amdgcn_permlane32_swap(__float_as_uint(ps), __float_as_uint(ps), false, false);
    ps = __uint_as_float(rr[0]) + __uint_as_float(rr[1]); }
  l_reg = l_reg * alpha + ps;
#define PK4(P, BASE, OUT) do { unsigned a0 = cvtpk(P[BASE + 0], P[BASE + 1]), a1 = cvtpk(P[BASE + 2], P[BASE + 3]);   \
    unsigned b0 = cvtpk(P[BASE + 4], P[BASE + 5]), b1 = cvtpk(P[BASE + 6], P[BASE + 7]);                              \
    auto r0 = __builtin_amdgcn_permlane32_swap(a0, b0, false, false); auto r1 = __builtin_amdgcn_permlane32_swap(a1, b1, false, false); \
    u32x4 w = {r0[0], r1[0], r0[1], r1[1]}; OUT = *reinterpret_cast<bf16x8*>(&w); } while (0)
  PK4(p0, 0, pa0); PK4(p0, 8, pa1); PK4(p1, 0, pa2); PK4(p1, 8, pa3);
#undef PK4
}
__device__ __forceinline__ void qkt(f32x16& p0, f32x16& p1, const bf16* Ks, const bf16x8* qr, int r32, int hi) {
  p0 = f32x16{}; p1 = f32x16{};
  for (int d0 = 0; d0 < 8; ++d0) { int cb = (d0 * 16 + hi * 8) * 2;
    bf16x8 b0 = *reinterpret_cast<const bf16x8*>((const char*)Ks + KSWZ(r32, cb));
    bf16x8 b1 = *reinterpret_cast<const bf16x8*>((const char*)Ks + KSWZ(32 + r32, cb));
    p0 = __builtin_amdgcn_mfma_f32_32x32x16_bf16(b0, qr[d0], p0, 0, 0, 0);
    p1 = __builtin_amdgcn_mfma_f32_32x32x16_bf16(b1, qr[d0], p1, 0, 0, 0); }
}
__device__ __forceinline__ int v_st(int k, int c) { const int kk = (k & ~0xC) | ((k & 4) << 1) | ((k & 8) >> 1); return ((kk >> 3) * 4 + (c >> 5)) * 512 + ((kk & 7) * 32 + (c & 31)) * 2; }
__device__ __forceinline__ int v_rd_base(int lane) { return ((lane & 3) << 3) | (((lane >> 2) & 3) << 6) | (((lane >> 4) & 1) << 5) | (((lane >> 5) & 1) << 8); }
constexpr int v_rd_off(int d0, int ks, int half) { return d0 * 512 + ks * 4096 + half * 2048; }
template <int OFF> __device__ __forceinline__ s16x4 tr_read(int vb) {
  s16x4 r; asm volatile("ds_read_b64_tr_b16 %0, %1 offset:%2" : "=&v"(r) : "v"(vb), "i"(OFF) : "memory"); return r;
}
template <int D0> __device__ __forceinline__ void pv_one(f32x16& od, int vb, bf16x8 pa0, bf16x8 pa1, bf16x8 pa2, bf16x8 pa3) {
  const s16x4 l0 = tr_read<v_rd_off(D0, 0, 0)>(vb), h0 = tr_read<v_rd_off(D0, 0, 1)>(vb), l1 = tr_read<v_rd_off(D0, 1, 0)>(vb), h1 = tr_read<v_rd_off(D0, 1, 1)>(vb);
  const s16x4 l2 = tr_read<v_rd_off(D0, 2, 0)>(vb), h2 = tr_read<v_rd_off(D0, 2, 1)>(vb), l3 = tr_read<v_rd_off(D0, 3, 0)>(vb), h3 = tr_read<v_rd_off(D0, 3, 1)>(vb);
  asm volatile("s_waitcnt lgkmcnt(0)" ::: "memory"); SBAR();
#define PK(L, H) (bf16x8){L[0], L[1], L[2], L[3], H[0], H[1], H[2], H[3]}
  od = __builtin_amdgcn_mfma_f32_32x32x16_bf16(pa0, PK(l0, h0), od, 0, 0, 0);
  od = __builtin_amdgcn_mfma_f32_32x32x16_bf16(pa1, PK(l1, h1), od, 0, 0, 0);
  od = __builtin_amdgcn_mfma_f32_32x32x16_bf16(pa2, PK(l2, h2), od, 0, 0, 0);
  od = __builtin_amdgcn_mfma_f32_32x32x16_bf16(pa3, PK(l3, h3), od, 0, 0, 0);
#undef PK
}
__device__ __forceinline__ void pv_d0(f32x16* o, int vb, bf16x8 pa0, bf16x8 pa1, bf16x8 pa2, bf16x8 pa3) {
  pv_one<0>(o[0], vb, pa0, pa1, pa2, pa3); pv_one<1>(o[1], vb, pa0, pa1, pa2, pa3); pv_one<2>(o[2], vb, pa0, pa1, pa2, pa3); pv_one<3>(o[3], vb, pa0, pa1, pa2, pa3);
}

template <typename TQ>
__device__ __forceinline__ void attn_dense_body(const TQ* Qb, const bf16* __restrict__ Kh, const bf16* __restrict__ Vh,
                                                bf16* Ob, int seq, char* lds) {
  using St = Stage<bf16>; using SQ = Stage<TQ>;
  const int tid = threadIdx.x, wid = tid >> 6, lane = tid & 63, r32 = lane & 31, hi = lane >> 5;
  bf16* V_lds = (bf16*)lds; bf16* K_lds = (bf16*)(lds + 2 * SHM_V);
  float* ws = (float*)(lds + 2 * SHM_V + 2 * SHM_K) + wid * 64; float* li_l = ws; float* al_l = ws + 32;
  float m_reg = -1e30f, l_reg = 0; f32x16 o[4] = {}; bf16x8 qr[8];
  const TQ* Qw = Qb + (long)(wid * QBLK + r32) * LDQ + hi * 8;
#pragma unroll
  for (int d0 = 0; d0 < 8; ++d0) qr[d0] = SQ::tobf(SQ::ld8(Qw + d0 * 16));
  const int sr = tid >> 4, sc = (tid & 15) * 8, vst0 = v_st(sr, sc), vst1 = v_st(32 + sr, sc);
  const int vb0 = (int)(uintptr_t)V_lds + v_rd_base(lane);
  struct { typename St::T vs0, vs1, ks0, ks1; } sr_[SDEPTH];
#define SLOAD(i, k0) do { sr_[i].vs0 = St::ld8(&Vh[(long)((k0) + sr) * LDK + sc]); sr_[i].vs1 = St::ld8(&Vh[(long)((k0) + 32 + sr) * LDK + sc]); \
    sr_[i].ks0 = St::ld8(&Kh[(long)((k0) + sr) * LDK + sc]); sr_[i].ks1 = St::ld8(&Kh[(long)((k0) + 32 + sr) * LDK + sc]); } while (0)
#define SWRITE(b, i) do { *(bf16x8*)((char*)V_lds + (b) * SHM_V + vst0) = St::tobf(sr_[i].vs0);          \
    *(bf16x8*)((char*)V_lds + (b) * SHM_V + vst1) = St::tobf(sr_[i].vs1); int kc = sc * 2;               \
    *(bf16x8*)((char*)K_lds + (b) * SHM_K + KSWZ(sr, kc)) = St::tobf(sr_[i].ks0);                       \
    *(bf16x8*)((char*)K_lds + (b) * SHM_K + KSWZ(32 + sr, kc)) = St::tobf(sr_[i].ks1); } while (0)
#define SWAIT() do { if constexpr (SDEPTH == 2) asm volatile("s_waitcnt vmcnt(4)" ::: "memory"); else asm volatile("s_waitcnt vmcnt(0)" ::: "memory"); } while (0)
#define RESC(a) do { if (__any((a) < 1.f)) { if (hi == 0) al_l[r32] = (a); asm volatile("s_waitcnt lgkmcnt(0)" ::: "memory"); \
    for (int d = 0; d < 4; ++d) for (int r = 0; r < 16; ++r) o[d][r] *= al_l[crow(r, hi)]; } } while (0)
  f32x16 pA0, pA1, pB0, pB1; float mnA, mnB, alA, alB; bf16x8 pa0, pa1, pa2, pa3; const int NT = seq / KVBLK;
  constexpr int SE = 0, SO = SDEPTH - 1;
  SLOAD(SE, 0); asm volatile("s_waitcnt vmcnt(0)" ::: "memory"); SWRITE(0, SE); __syncthreads();
  qkt(pA0, pA1, K_lds, qr, r32, hi); partialSM(pA0, pA1, m_reg, mnA, alA);
  SLOAD(SO, KVBLK); if constexpr (SDEPTH == 2) { if (2 < NT) SLOAD(SE, 2 * KVBLK); }
  SWAIT(); SWRITE(1, SO); __syncthreads();
  for (int j = 1; j + 1 < NT; j += 2) {
    SBAR(); qkt(pB0, pB1, (bf16*)((char*)K_lds + SHM_K), qr, r32, hi);
    finishSM(pA0, pA1, alA, l_reg, pa0, pa1, pa2, pa3); SBAR();
    SLOAD(SO, (j + SDEPTH) * KVBLK); SBAR();
    pv_d0(o, vb0, pa0, pa1, pa2, pa3); partialSM(pB0, pB1, m_reg, mnB, alB);
    __syncthreads(); SWAIT(); SWRITE(0, SE);
    RESC(alB); __syncthreads();
    SBAR(); qkt(pA0, pA1, K_lds, qr, r32, hi);
    finishSM(pB0, pB1, alB, l_reg, pa0, pa1, pa2, pa3); SBAR();
    if (SDEPTH == 1 || j + 3 < NT) SLOAD(SE, (j + 1 + SDEPTH) * KVBLK); SBAR();
    pv_d0(o, vb0 + (int)SHM_V, pa0, pa1, pa2, pa3); partialSM(pA0, pA1, m_reg, mnA, alA);
    __syncthreads(); SWAIT(); SWRITE(1, SO);
    RESC(alA); __syncthreads();
  }
  SBAR(); qkt(pB0, pB1, (bf16*)((char*)K_lds + SHM_K), qr, r32, hi);
  finishSM(pA0, pA1, alA, l_reg, pa0, pa1, pa2, pa3); SBAR();
  pv_d0(o, vb0, pa0, pa1, pa2, pa3); partialSM(pB0, pB1, m_reg, mnB, alB);
  __syncthreads(); RESC(alB);
  finishSM(pB0, pB1, alB, l_reg, pa0, pa1, pa2, pa3); SBAR();
  pv_d0(o, vb0 + (int)SHM_V, pa0, pa1, pa2, pa3);
  if (hi == 0) li_l[r32] = l_reg; asm volatile("s_waitcnt lgkmcnt(0)" ::: "memory");
  float rli[16];
#pragma unroll
  for (int r = 0; r < 16; ++r) rli[r] = __builtin_amdgcn_rcpf(li_l[crow(r, hi)]);
  bf16* Ow = Ob + (long)(wid * QBLK) * LDO;
#pragma unroll
  for (int r = 0; r < 16; ++r) { int orow = crow(r, hi);
#pragma unroll
    for (int d0 = 0; d0 < 4; ++d0) Ow[(long)orow * LDO + d0 * 32 + r32] = (bf16)f2bf(o[d0][r] * rli[r]); }
  __syncthreads();
#undef SLOAD
#undef SWRITE
#undef SWAIT
#undef RESC
}
#undef KSWZ
#undef SBAR
}

namespace gla {
typedef __attribute__((address_space(3))) unsigned char* lptr;
typedef __attribute__((address_space(3))) const char* lds_cptr;
typedef short v4i16_t __attribute__((ext_vector_type(4)));
typedef short s16x4 __attribute__((ext_vector_type(4)));
__device__ __forceinline__ s16x4 vtr(lds_cptr p) { return __builtin_bit_cast(s16x4, __builtin_amdgcn_ds_read_tr16_b64_v4i16((__attribute__((address_space(3))) v4i16_t*)p)); }
__device__ __forceinline__ unsigned cvtpk(float lo, float hi) { unsigned r; asm volatile("v_cvt_pk_bf16_f32 %0, %1, %2" : "=v"(r) : "v"(lo), "v"(hi)); return r; }
__device__ __forceinline__ float logsig16(float x) {
    const float e = __builtin_amdgcn_exp2f(-__builtin_fabsf(x) * 1.4426950408889634f);
    const float l = __builtin_amdgcn_logf(1.f + e) * 0.6931471805599453f;
    return (__builtin_fminf(x, 0.f) - l) * 0.0625f;
}
__device__ __forceinline__ float expf_(float x) { return __builtin_amdgcn_exp2f(x * 1.4426950408889634f); }

struct Ptrs {
    bf16_t* GK; const bf16_t* GV; bf16_t* GQ; bf16_t* QEB; bf16_t* KDB; float* GAM; bf16_t* AM; bf16_t* OI; bf16_t* GO; const float* LR;
    const float *w_gk_f, *b_gk_f, *w_gk_b, *b_gk_b, *gla_norm;
};

constexpr int G1_LR = 0, G1_TOT = 8192, G1_QE = 12288, G1_PITCH = 136, G1_KE = G1_QE + 2 * 64 * G1_PITCH * 2;
static_assert(G1_KE + 2 * 64 * G1_PITCH * 2 <= 131072, "G1 LDS");

__device__ __forceinline__ void g1_unit(const Ptrs& p, int bh, int ci, lptr lds, int tid) {
    const int b = bh >> 2, h = bh & 3, d = tid & 127, tq = tid >> 7;
    const size_t pr0 = (size_t)b * P + (size_t)ci * 64;
    const bool isx = ci >= 4; const size_t m0 = (size_t)b * T + (size_t)(ci - 4) * 64;
    __attribute__((address_space(3))) float* LRs = (__attribute__((address_space(3))) float*)(lds + G1_LR);
    __attribute__((address_space(3))) float* TOT = (__attribute__((address_space(3))) float*)(lds + G1_TOT);
    __attribute__((address_space(3))) bf16_t* QEs = (__attribute__((address_space(3))) bf16_t*)(lds + G1_QE);
    __attribute__((address_space(3))) bf16_t* KEs = (__attribute__((address_space(3))) bf16_t*)(lds + G1_KE);
    { const f32x4 v = *(const f32x4*)(p.LR + (pr0 + (tid >> 3)) * 32 + (tid & 7) * 4); *(__attribute__((address_space(3))) f32x4*)(LRs + (tid >> 3) * 32 + (tid & 7) * 4) = v; }
    float kv[16], qv[16];
#pragma unroll
    for (int i = 0; i < 16; ++i) kv[i] = bf2f(p.GK[(pr0 + 16 * tq + i) * 512 + h * 128 + d]);
#pragma unroll
    for (int i = 0; i < 16; ++i) qv[i] = isx ? bf2f(p.GQ[(m0 + 16 * tq + i) * 512 + h * 128 + d]) : 0.f;
    asm volatile("s_waitcnt vmcnt(0)" ::: "memory");
    __syncthreads();
    float cs[2][16];
#pragma unroll
    for (int dir = 0; dir < 2; ++dir) {
        const float* wg = dir ? p.w_gk_b : p.w_gk_f; const float bias = (dir ? p.b_gk_b : p.b_gk_f)[h * 128 + d];
        float w[16];
#pragma unroll
        for (int r = 0; r < 16; ++r) w[r] = wg[r * 512 + h * 128 + d];
        float g[16];
#pragma unroll
        for (int i = 0; i < 16; ++i) { float x = bias;
#pragma unroll
            for (int r = 0; r < 16; ++r) x += LRs[(16 * tq + i) * 32 + dir * 16 + r] * w[r];
            g[i] = logsig16(x); }
        float run = 0.f;
        if (dir == 0) {
#pragma unroll
            for (int i = 0; i < 16; ++i) { run += g[i]; cs[0][i] = run; }
        } else {
#pragma unroll
            for (int i = 15; i >= 0; --i) { run += g[i]; cs[1][i] = run; }
        }
        TOT[(dir * 4 + tq) * 128 + d] = run;
    }
    __syncthreads();
#pragma unroll
    for (int dir = 0; dir < 2; ++dir) {
        const float t0 = TOT[(dir * 4 + 0) * 128 + d], t1 = TOT[(dir * 4 + 1) * 128 + d], t2 = TOT[(dir * 4 + 2) * 128 + d], t3 = TOT[(dir * 4 + 3) * 128 + d];
        const float btot = (t0 + t1) + (t2 + t3);
        float off;
        if (dir == 0) off = (tq > 0 ? t0 : 0.f) + (tq > 1 ? t1 : 0.f) + (tq > 2 ? t2 : 0.f);
        else          off = (tq < 1 ? t1 : 0.f) + (tq < 2 ? t2 : 0.f) + (tq < 3 ? t3 : 0.f);
        unsigned kdw[8];
#pragma unroll
        for (int i = 0; i < 16; i += 2) { const float b0 = off + cs[dir][i], b1 = off + cs[dir][i + 1];
            kdw[i >> 1] = cvtpk(kv[i] * expf_(btot - b0), kv[i + 1] * expf_(btot - b1)); }
        bf16_t* kdp = dir == 0 ? p.GK + (pr0 + (size_t)(d >> 1)) * 512 + h * 128 + (d & 1) * 64 + 16 * tq
                               : p.KDB + (((size_t)bh * NCH + ci) * 128 + d) * 64 + 16 * tq;
        *(u32x4*)kdp = (u32x4){kdw[0], kdw[1], kdw[2], kdw[3]}; *(u32x4*)(kdp + 8) = (u32x4){kdw[4], kdw[5], kdw[6], kdw[7]};
        if (tq == 0) p.GAM[(((size_t)dir * 16 + bh) * NCH + ci) * 128 + d] = expf_(btot);
        if (isx) {
            bf16_t* qdst = (dir == 0 ? p.GQ : p.QEB) + (m0 + 16 * tq) * 512 + h * 128 + d;
#pragma unroll
            for (int i = 0; i < 16; ++i) { const float bi = off + cs[dir][i];
                const bf16_t qe = (bf16_t)f2bf(qv[i] * expf_(bi)), ke = (bf16_t)f2bf(kv[i] * expf_(-bi));
                qdst[(size_t)i * 512] = qe;
                QEs[(dir * 64 + 16 * tq + i) * G1_PITCH + d] = qe; KEs[(dir * 64 + 16 * tq + i) * G1_PITCH + d] = ke; }
        }
    }
    __syncthreads();
    if (isx) {
        const int wave = tid >> 6, lane = tid & 63, fr = lane & 15, fq = lane >> 4, ti = wave >> 1;
        bf16_t* am = p.AM + ((size_t)bh * 64 + (ci - 4)) * 4096;
#pragma unroll
        for (int jj = 0; jj < 2; ++jj) { const int tj = 2 * (wave & 1) + jj;
            f32x4 aF = {0.f, 0.f, 0.f, 0.f}, aB = {0.f, 0.f, 0.f, 0.f};
#pragma unroll
            for (int ks = 0; ks < 4; ++ks) {
                const bf16x8 qf = *(const __attribute__((address_space(3))) bf16x8*)(QEs + (16 * ti + fr) * G1_PITCH + 32 * ks + 8 * fq);
                const bf16x8 kf = *(const __attribute__((address_space(3))) bf16x8*)(KEs + (16 * tj + fr) * G1_PITCH + 32 * ks + 8 * fq);
                const bf16x8 qb = *(const __attribute__((address_space(3))) bf16x8*)(QEs + (64 + 16 * ti + fr) * G1_PITCH + 32 * ks + 8 * fq);
                const bf16x8 kb = *(const __attribute__((address_space(3))) bf16x8*)(KEs + (64 + 16 * tj + fr) * G1_PITCH + 32 * ks + 8 * fq);
                aF = __builtin_amdgcn_mfma_f32_16x16x32_bf16(qf, kf, aF, 0, 0, 0);
                aB = __builtin_amdgcn_mfma_f32_16x16x32_bf16(qb, kb, aB, 0, 0, 0);
            }
#pragma unroll
            for (int r = 0; r < 4; ++r) { const int i = 16 * ti + 4 * fq + r, j = 16 * tj + fr;
                const float v = (j <= i ? aF[r] : 0.f) + (j >= i ? aB[r] : 0.f);
                am[i * 64 + j] = (bf16_t)f2bf(v); }
        }
    }
    __syncthreads();
}

__device__ __forceinline__ void g2_wave(const Ptrs& p, int pair, int dir, lptr vs, volatile __attribute__((address_space(3))) unsigned* prog, int lane) {
    const int bh = pair >> 4, dvb = pair & 15, b = bh >> 2, h = bh & 3, fr = lane & 15, fq = lane >> 4;
    f32x4 S[8];
#pragma unroll
    for (int td = 0; td < 8; ++td) S[td] = (f32x4){0.f, 0.f, 0.f, 0.f};
    const bf16_t* QE = dir == 0 ? p.GQ : p.QEB;
    for (int s = 0; s < NCH; ++s) {
        const int ci = dir == 0 ? s : (s < 4 ? 3 - s : 71 - s);
        const size_t pr0 = (size_t)b * P + (size_t)ci * 64;
        const bool isx = ci >= 4; const int c = ci - 4; const size_t m0 = (size_t)b * T + (size_t)c * 64;
        const bf16_t* vp = p.GV + (pr0 + lane) * 1024 + h * 256 + 16 * dvb;
        const u32x4 v0 = *(const u32x4*)vp, v1 = *(const u32x4*)(vp + 8);
        if (isx) {
            bf16x8 Sb[4];
#pragma unroll
            for (int u = 0; u < 4; ++u) { const u32x4 w = {cvtpk(S[2 * u][0], S[2 * u][1]), cvtpk(S[2 * u][2], S[2 * u][3]), cvtpk(S[2 * u + 1][0], S[2 * u + 1][1]), cvtpk(S[2 * u + 1][2], S[2 * u + 1][3])};
                Sb[u] = __builtin_bit_cast(bf16x8, w); }
            const bool second = dir == 0 ? (c >= 32) : (c <= 31);
            if (second) { const unsigned need = dir == 0 ? (unsigned)(68 - c) : (unsigned)(c + 5); unsigned sp = 0;
                while (prog[1 - dir] < need) { __builtin_amdgcn_s_sleep(2); if (++sp > (1u << 22)) break; } }
            const bf16_t* qp = QE + (m0 + fr) * 512 + h * 128 + 4 * fq;
            bf16_t* op = p.OI + (m0 + 4 * fq) * 1024 + h * 256 + 16 * dvb + fr;
#pragma unroll
            for (int tt = 0; tt < 4; ++tt) {
                f32x4 acc = {0.f, 0.f, 0.f, 0.f};
#pragma unroll
                for (int u = 0; u < 4; ++u) {
                    const u32x2 lo = *(const u32x2*)(qp + (size_t)(16 * tt) * 512 + 32 * u), hi = *(const u32x2*)(qp + (size_t)(16 * tt) * 512 + 32 * u + 16);
                    const u32x4 aw = {lo.x, lo.y, hi.x, hi.y};
                    acc = __builtin_amdgcn_mfma_f32_16x16x32_bf16(__builtin_bit_cast(bf16x8, aw), Sb[u], acc, 0, 0, 0);
                }
#pragma unroll
                for (int r = 0; r < 4; ++r) { bf16_t* o1 = op + (size_t)(16 * tt + r) * 1024; float v = acc[r]; if (second) v += bf2f(*o1); *o1 = (bf16_t)f2bf(v); }
            }
        }
        { __attribute__((address_space(3))) u32x2* w = (__attribute__((address_space(3))) u32x2*)(vs + lane * 40);
          w[0] = (u32x2){v0.x, v0.y}; w[1] = (u32x2){v0.z, v0.w}; w[2] = (u32x2){v1.x, v1.y}; w[3] = (u32x2){v1.z, v1.w}; }
        bf16x8 vB[2];
#pragma unroll
        for (int ks = 0; ks < 2; ++ks) {
            const lds_cptr a0 = (lds_cptr)vs + (32 * ks + 8 * fq + (fr >> 2)) * 40 + (fr & 3) * 8;
            const s16x4 l = vtr(a0), hh = vtr(a0 + 4 * 40);
            vB[ks] = (bf16x8){l[0], l[1], l[2], l[3], hh[0], hh[1], hh[2], hh[3]};
        }
        const float* gp = p.GAM + (((size_t)dir * 16 + bh) * NCH + ci) * 128 + 4 * fq;
#pragma unroll
        for (int td = 0; td < 8; ++td) {
            const int d = 16 * td + fr;
            const bf16_t* kp = dir == 0 ? p.GK + (pr0 + (size_t)(d >> 1)) * 512 + h * 128 + (d & 1) * 64 + 8 * fq
                                        : p.KDB + (((size_t)bh * NCH + ci) * 128 + d) * 64 + 8 * fq;
            const bf16x8 a0 = *(const bf16x8*)kp, a1 = *(const bf16x8*)(kp + 32);
            const f32x4 gm = *(const f32x4*)(gp + 16 * td);
            f32x4 sv = S[td] * gm;
            sv = __builtin_amdgcn_mfma_f32_16x16x32_bf16(a0, vB[0], sv, 0, 0, 0);
            sv = __builtin_amdgcn_mfma_f32_16x16x32_bf16(a1, vB[1], sv, 0, 0, 0);
            S[td] = sv;
        }
        asm volatile("s_waitcnt vmcnt(0)" ::: "memory");
        if (lane == 0) prog[dir] = (unsigned)(s + 1);
    }
}

constexpr int G3_SS = 32768;
__device__ __forceinline__ void g3_unit(const Ptrs& p, int bh, int c, lptr lds, int tid) {
    const int b = bh >> 2, h = bh & 3, wave = tid >> 6, lane = tid & 63, r32 = lane & 31, hi = lane >> 5;
    const size_t pr0 = (size_t)b * P + (size_t)(c + 4) * 64, m0 = (size_t)b * T + (size_t)c * 64;
    { const int sr = tid >> 4, sc = (tid & 15) * 8;
#pragma unroll
      for (int tile = 0; tile < 2; ++tile)
#pragma unroll
          for (int rr = 0; rr < 2; ++rr) { const int row = sr + 32 * rr;
              const bf16x8 x = *(const bf16x8*)(p.GV + (pr0 + row) * 1024 + h * 256 + tile * 128 + sc);
              *(__attribute__((address_space(3))) bf16x8*)(lds + tile * 16384 + att::v_st(row, sc)) = x; } }
    const int tt = wave & 1, dq = wave >> 1, t = 32 * tt + r32;
    const bf16_t* ap = p.AM + (((size_t)bh * 64 + c) * 64 + t) * 64 + 8 * hi;
    bf16x8 bfr[4];
#pragma unroll
    for (int ks = 0; ks < 4; ++ks) bfr[ks] = *(const bf16x8*)(ap + 16 * ks);
    __syncthreads();
    f32x16 od[2];
#pragma unroll
    for (int k2 = 0; k2 < 2; ++k2) {
#pragma unroll
        for (int r = 0; r < 16; ++r) od[k2][r] = 0.f;
        const int dvt = 2 * dq + k2, tile = dvt >> 2, d0 = dvt & 3;
        const lds_cptr vb = (lds_cptr)lds + tile * 16384 + att::v_rd_base(lane) + d0 * 512;
#pragma unroll
        for (int ks = 0; ks < 4; ++ks) {
            const s16x4 l = vtr(vb + ks * 4096), hh = vtr(vb + ks * 4096 + 2048);
            const bf16x8 va = (bf16x8){l[0], l[1], l[2], l[3], hh[0], hh[1], hh[2], hh[3]};
            od[k2] = __builtin_amdgcn_mfma_f32_32x32x16_bf16(va, bfr[ks], od[k2], 0, 0, 0);
        }
    }
    const size_t rowp = (m0 + t) * 1024 + h * 256;
    float ss = 0.f;
#pragma unroll
    for (int k2 = 0; k2 < 2; ++k2)
#pragma unroll
        for (int g4 = 0; g4 < 4; ++g4) { const int dv0 = 64 * dq + 32 * k2 + 8 * g4 + 4 * hi;
            const u32x2 w = *(const u32x2*)(p.OI + rowp + dv0);
            od[k2][4 * g4 + 0] += bflo(w.x); od[k2][4 * g4 + 1] += bfhi(w.x); od[k2][4 * g4 + 2] += bflo(w.y); od[k2][4 * g4 + 3] += bfhi(w.y);
#pragma unroll
            for (int e = 0; e < 4; ++e) ss += od[k2][4 * g4 + e] * od[k2][4 * g4 + e]; }
    ss += __shfl_xor(ss, 32);
    __attribute__((address_space(3))) float* SS = (__attribute__((address_space(3))) float*)(lds + G3_SS);
    if (hi == 0) SS[t * 4 + dq] = ss;
    __syncthreads();
    const float tot = (SS[t * 4 + 0] + SS[t * 4 + 1]) + (SS[t * 4 + 2] + SS[t * 4 + 3]);
    const float rstd = __builtin_amdgcn_rsqf(tot * (1.f / 256.f) + EPS);
#pragma unroll
    for (int k2 = 0; k2 < 2; ++k2)
#pragma unroll
        for (int g4 = 0; g4 < 4; ++g4) { const int dv0 = 64 * dq + 32 * k2 + 8 * g4 + 4 * hi;
            const u32x2 gw = *(const u32x2*)(p.GO + rowp + dv0); const f32x4 gn = *(const f32x4*)(p.gla_norm + dv0);
            const float g0 = bflo(gw.x), g1 = bfhi(gw.x), g2 = bflo(gw.y), g3 = bfhi(gw.y);
            const float y0 = od[k2][4 * g4 + 0] * rstd * gn[0] * (g0 * sigmoidf_(g0)), y1 = od[k2][4 * g4 + 1] * rstd * gn[1] * (g1 * sigmoidf_(g1));
            const float y2 = od[k2][4 * g4 + 2] * rstd * gn[2] * (g2 * sigmoidf_(g2)), y3 = od[k2][4 * g4 + 3] * rstd * gn[3] * (g3 * sigmoidf_(g3));
            *(u32x2*)(p.GO + rowp + dv0) = (u32x2){cvtpk(y0, y1), cvtpk(y2, y3)}; }
    __syncthreads();
}
}


constexpr int RING_OFF = 0, RING_BYTES = 131072;
constexpr int LDSCTL_OFF = RING_BYTES, MISC_OFF = LDSCTL_OFF + 320;
constexpr int LDS_BYTES = 147456;
constexpr int NWAVES = 8;
constexpr int CW_BAR = 4096;

enum Phase { PH_PRO = 0, PH_NORM1, PH_INPROJ, PH_QKROPE, PH_ATTN, PH_G1, PH_G2, PH_G3, PH_MERGE, PH_OUT, PH_NORM2, PH_MLP1, PH_MLP2, PH_END };

struct Args { const float* in[21]; float* out; unsigned char* ws; int ph_lo, ph_hi; };

__device__ __forceinline__ void lr_unit(const bf16_t* __restrict__ XNall, const bf16_t* __restrict__ WlrT, float* __restrict__ LR, int u, int wave, int lane) {
    const int r32 = lane & 31, hi = lane >> 5;
    const bf16_t* ap = XNall + (size_t)(u * 256 + wave * 32 + r32) * 1024 + hi * 8;
    const bf16_t* bp = WlrT + (size_t)r32 * 1024 + hi * 8;
    f32x16 acc;
#pragma unroll
    for (int r = 0; r < 16; ++r) acc[r] = 0.f;
#pragma unroll 8
    for (int k0 = 0; k0 < 1024; k0 += 16) {
        const bf16x8 a = *(const bf16x8*)(ap + k0), b = *(const bf16x8*)(bp + k0);
        acc = __builtin_amdgcn_mfma_f32_32x32x16_bf16(a, b, acc, 0, 0, 0);
    }
#pragma unroll
    for (int r = 0; r < 16; ++r) { const int m = u * 256 + wave * 32 + crow(r, hi); LR[prow(m) * 32 + r32] = acc[r]; }
}

__global__ void __launch_bounds__(NWAVES * 64, 2) mk_fwd(Args args) {
    extern __shared__ __attribute__((aligned(16))) unsigned char lds[];
    LAS unsigned char* ldsl = (LAS unsigned char*)lds;
    volatile LAS unsigned* MISC = (volatile LAS unsigned*)(ldsl + MISC_OFF);
    const int tid = threadIdx.x, lane = tid & 63, wave = __builtin_amdgcn_readfirstlane(tid >> 6);
    const int G = gridDim.x, bx = blockIdx.x;
    unsigned char* ws = args.ws;
    gu32* ctl = (gu32*)(ws + WS_CTL);
    float* out = args.out;
    float* MODX = (float*)(ws + WS_MODX);
    bf16_t* WinT = (bf16_t*)(ws + WS_WIN); bf16_t* WaT = (bf16_t*)(ws + WS_WA); bf16_t* WgT = (bf16_t*)(ws + WS_WG); bf16_t* WoT = (bf16_t*)(ws + WS_WO);
    bf16_t* W1T = (bf16_t*)(ws + WS_W1); bf16_t* W2T = (bf16_t*)(ws + WS_W2);
    bf16_t* KA = (bf16_t*)(ws + WS_KA); bf16_t* VA = (bf16_t*)(ws + WS_VA); bf16_t* GK = (bf16_t*)(ws + WS_GK); bf16_t* GV = (bf16_t*)(ws + WS_GV); float* LR = (float*)(ws + WS_LR);
    bf16_t* QA = (bf16_t*)(ws + WS_QA); bf16_t* GQ = (bf16_t*)(ws + WS_GQ); bf16_t* GO = (bf16_t*)(ws + WS_GO); bf16_t* GA = (bf16_t*)(ws + WS_GA); bf16_t* GG = (bf16_t*)(ws + WS_GG);
    bf16_t* Y = (bf16_t*)(ws + WS_Y); bf16_t* HN = (bf16_t*)(ws + WS_HN); bf16_t* H = (bf16_t*)(ws + WS_H);
    bf16_t* XN = (bf16_t*)args.out;

    for (int u = tid; u < (LDS_BYTES - LDSCTL_OFF) / 4; u += NWAVES * 64) ((LAS unsigned*)(ldsl + LDSCTL_OFF))[u] = 0u;
    __syncthreads();
    const int lo = args.ph_lo, hi = args.ph_hi;
    const bool multi = (hi - lo) > 1;
    XcdBarrier bar; bar.bar = (unsigned*)(ctl + CW_BAR); bar.x = 0; bar.st = nullptr;
    if (multi) bar = xcd_barrier_post((unsigned*)(ctl + CW_BAR), MISC + 8);
#define IN(k) (lo <= (k) && (k) < hi)
#define SEAM(k) do { if (IN(k) && IN((k) + 1)) xcd_barrier(bar); } while (0)

    if (IN(PH_INPROJ)) {
        pg8::Gemm g{XN, WinT, MALL, NIN, DM}; pg8::InOrder S; S.init(G, bx);
        pg8::EpiInProj E{KA, VA, GK, GV, QA, GQ, GO, GA, GG};
        pg8::gemm_phase<pg8::EpiInProj, pg8::InOrder, true, true>(ldsl + RING_OFF, g, S, E);
        if (bx >= 160 && bx < 160 + 68) lr_unit(XN, WinT + (size_t)NIN * DM, LR, bx - 160, wave, lane);
    }
    SEAM(PH_INPROJ);
    if (IN(PH_ATTN)) {
        for (int L = bx; L < 512; L += G) { const int xg = L & 7, u = L >> 3, b = xg >> 1, kvh = xg & 1, h = kvh * 4 + (u >> 4), qb = u & 15;
            bf16_t* Qb = QA + ((size_t)(b * T + qb * 256)) * 1024 + h * 128;
            att::attn_dense_body<att::bf16>(Qb, KA + (size_t)b * P * 256 + kvh * 128, VA + (size_t)b * P * 256 + kvh * 128, Qb, P, (char*)lds + RING_OFF); }
    }
    SEAM(PH_ATTN);
    gla::Ptrs gp{GK, GV, GQ, (bf16_t*)(ws + WS_QEB), (bf16_t*)((unsigned char*)args.out + DO_KDB), (float*)(ws + WS_GAM), (bf16_t*)((unsigned char*)args.out + DO_AM), (bf16_t*)((unsigned char*)args.out + DO_OI), GO, LR,
                 args.in[10], args.in[11], args.in[12], args.in[13], args.in[14]};
    if (IN(PH_G1)) { for (int L = bx; L < 16 * NCH; L += G) gla::g1_unit(gp, L & 15, L >> 4, ldsl + RING_OFF, tid); }
    SEAM(PH_G1);
    if (IN(PH_G2)) {
        volatile LAS unsigned* prog = (volatile LAS unsigned*)(ldsl + RING_OFF + 65536);
        for (int L = bx; L < 256; L += G) {
            if (tid == 0) { prog[0] = 0u; prog[1] = 0u; }
            __syncthreads();
            if (wave < 2) gla::g2_wave(gp, L, wave, ldsl + RING_OFF + wave * 4096, prog, lane);
            __syncthreads();
        }
    }
    SEAM(PH_G2);
    if (IN(PH_G3)) { for (int L = bx; L < 1024; L += G) gla::g3_unit(gp, L & 15, L >> 4, ldsl + RING_OFF, tid); }
    SEAM(PH_G3);
    if (IN(PH_MERGE)) {
        { pg8::Gemm g{QA, WaT, M, DM, DM}; pg8::StaticOrder S; S.init(M, DM, G, bx); pg8::EpiMerge<true> E{GA, Y};
          pg8::gemm_phase<pg8::EpiMerge<true>, pg8::StaticOrder, false, true>(ldsl + RING_OFF, g, S, E); }
        { pg8::Gemm g{GO, WgT, M, DM, DM}; pg8::StaticOrder S; S.init(M, DM, G, bx); pg8::EpiMerge<false> E{GG, Y};
          pg8::gemm_phase<pg8::EpiMerge<false>, pg8::StaticOrder, false, true>(ldsl + RING_OFF, g, S, E); }
    }
    SEAM(PH_MERGE);
    if (IN(PH_OUT)) {
        pg8::Gemm g{Y, WoT, M, DM, DM}; pg8::StaticOrder S; S.init(M, DM, G, bx); pg8::EpiGateRes E{args.in[0], out, MODX + 2 * DM};
        pg8::gemm_phase<pg8::EpiGateRes, pg8::StaticOrder, false, true>(ldsl + RING_OFF, g, S, E);
    }
    SEAM(PH_OUT);
    if (IN(PH_MLP1)) {
        pg8::Gemm g{HN, W1T, M, FF, DM}; pg8::StaticOrder S; S.init(M, FF, G, bx); pg8::EpiSqRelu E{H};
        pg8::gemm_phase<pg8::EpiSqRelu, pg8::StaticOrder, true, true>(ldsl + RING_OFF, g, S, E);
    }
    SEAM(PH_MLP1);
    if (IN(PH_MLP2)) {
        pg8::Gemm g{H, W2T, M, DM, FF}; pg8::StaticOrder S; S.init(M, DM, G, bx); pg8::EpiGateRes E{out, out, MODX + 5 * DM};
        pg8::gemm_phase<pg8::EpiGateRes, pg8::StaticOrder, false, true>(ldsl + RING_OFF, g, S, E);
    }
#undef IN
#undef SEAM
}

extern "C" void kernel_launch(void* const* d_in, const int* in_sizes, int n_in, void* d_out, int out_size, void* d_ws, size_t ws_size, hipStream_t stream) {
    (void)in_sizes; (void)n_in; (void)out_size; (void)ws_size;
    static int grid = 0;
    if (grid == 0) {
        int dev = 0, cus = 0, per_cu = 0;
        if (hipGetDevice(&dev) != hipSuccess || hipDeviceGetAttribute(&cus, hipDeviceAttributeMultiprocessorCount, dev) != hipSuccess) { fprintf(stderr, "kernel_launch: device query failed\n"); grid = -1; return; }
        if (hipFuncSetAttribute((const void*)mk_fwd, hipFuncAttributeMaxDynamicSharedMemorySize, LDS_BYTES) != hipSuccess) { fprintf(stderr, "kernel_launch: hipFuncSetAttribute failed\n"); grid = -1; return; }
        if (hipOccupancyMaxActiveBlocksPerMultiprocessor(&per_cu, (const void*)mk_fwd, NWAVES * 64, LDS_BYTES) != hipSuccess || per_cu < 1) { fprintf(stderr, "kernel_launch: occupancy query says %d blocks/CU\n", per_cu); per_cu = 1; }
        (void)hipGetLastError();
        grid = cus;
        if (grid != 256) fprintf(stderr, "kernel_launch: %d CUs (built for 256)\n", grid);
    }
    if (grid < 0) return;
    const float* x = (const float*)d_in[0]; const float* c = (const float*)d_in[1]; const float* ctx = (const float*)d_in[2]; const float* c_ctx = (const float*)d_in[3];
    const float* w_ada = (const float*)d_in[4]; const float* b_ada = (const float*)d_in[5]; const float* norm1 = (const float*)d_in[6]; const float* w_in = (const float*)d_in[7];
    const float* q_norm = (const float*)d_in[8]; const float* k_norm = (const float*)d_in[9]; const float* w_gk_f = (const float*)d_in[10]; const float* b_gk_f = (const float*)d_in[11];
    const float* w_gk_b = (const float*)d_in[12]; const float* b_gk_b = (const float*)d_in[13]; const float* gla_norm = (const float*)d_in[14]; const float* w_br_attn = (const float*)d_in[15];
    const float* w_br_gla = (const float*)d_in[16]; const float* w_out = (const float*)d_in[17]; const float* norm2 = (const float*)d_in[18]; const float* w_mlp1 = (const float*)d_in[19]; const float* w_mlp2 = (const float*)d_in[20];
    unsigned char* ws = (unsigned char*)d_ws; float* out = (float*)d_out;
    float* MODX = (float*)(ws + WS_MODX); float* MODC = (float*)(ws + WS_MODC); float* ROPE = (float*)(ws + WS_ROPE);
    bf16_t* WinT = (bf16_t*)(ws + WS_WIN); bf16_t* WaT = (bf16_t*)(ws + WS_WA); bf16_t* WgT = (bf16_t*)(ws + WS_WG); bf16_t* WoT = (bf16_t*)(ws + WS_WO);
    bf16_t* W1T = (bf16_t*)(ws + WS_W1); bf16_t* W2T = (bf16_t*)(ws + WS_W2);
    bf16_t* KA = (bf16_t*)(ws + WS_KA); bf16_t* VA = (bf16_t*)(ws + WS_VA); bf16_t* GK = (bf16_t*)(ws + WS_GK); bf16_t* GV = (bf16_t*)(ws + WS_GV); float* LR = (float*)(ws + WS_LR);
    bf16_t* QA = (bf16_t*)(ws + WS_QA); bf16_t* GQ = (bf16_t*)(ws + WS_GQ); bf16_t* GO = (bf16_t*)(ws + WS_GO);
    bf16_t* HN = (bf16_t*)(ws + WS_HN);
    bf16_t* XN = (bf16_t*)d_out; float* OF = (float*)d_out;
    (void)hipMemsetAsync(ws + WS_CTL, 0, CTL_ZERO_BYTES, stream);
    Args a{}; for (int i = 0; i < 21; ++i) a.in[i] = (const float*)d_in[i]; a.out = out; a.ws = ws;
    auto phase = [&](int p) { a.ph_lo = p; a.ph_hi = p + 1; hipLaunchKernelGGL(mk_fwd, dim3(grid), dim3(NWAVES * 64), LDS_BYTES, stream, a); };
    auto blocks = [](size_t n) { return (unsigned)((n + 255) / 256); };

    k_convT<<<blocks((size_t)6720 * DM), 256, 0, stream>>>(w_in, DM, 6688, WinT, 6720, 1);
    k_convT<<<blocks((size_t)DM * DM), 256, 0, stream>>>(w_br_attn, DM, DM, WaT, DM, 0);
    k_convT<<<blocks((size_t)DM * DM), 256, 0, stream>>>(w_br_gla, DM, DM, WgT, DM, 0);
    k_convT<<<blocks((size_t)DM * DM), 256, 0, stream>>>(w_out, DM, DM, WoT, DM, 0);
    k_adaln<<<dim3(24, 5), 256, 0, stream>>>(c, c_ctx, w_ada, b_ada, MODX, MODC);
    k_rope_table<<<8, 256, 0, stream>>>(ROPE);
    k_norm_mod<<<M / 4, 256, 0, stream>>>(x, M, T, norm1, MODX, 6 * DM, 0, DM, XN);
    k_norm_mod<<<MC / 4, 256, 0, stream>>>(ctx, MC, MC, norm1, MODC, 0, 0, DM, XN + (size_t)M * DM);
    phase(PH_INPROJ);
    k_qknorm_rope<<<(M * 8) / 4, 256, 0, stream>>>(QA, M, 8, 1024, q_norm, ROPE, 0);
    k_qknorm_rope<<<(NB * P * 2) / 4, 256, 0, stream>>>(KA, NB * P, 2, 256, k_norm, ROPE, 1);
    phase(PH_ATTN);
    phase(PH_G1); phase(PH_G2); phase(PH_G3);
    k_convT<<<blocks((size_t)FF * DM), 256, 0, stream>>>(w_mlp1, DM, FF, W1T, FF, 0);
    k_convT<<<blocks((size_t)FF * DM), 256, 0, stream>>>(w_mlp2, FF, DM, W2T, DM, 0);
    phase(PH_MERGE);
    phase(PH_OUT);
    k_norm_mod<<<M / 4, 256, 0, stream>>>(out, M, T, norm2, MODX, 6 * DM, 3 * DM, 4 * DM, HN);
    phase(PH_MLP1);
    phase(PH_MLP2);
}
```

```cpp
#include <hip/hip_runtime.h>
#include <cstdio>
#include <cstdint>

constexpr int NB = 4, T = 4096, DM = 1024, CTX = 256, P = CTX + T  ;
constexpr int M = NB * T, MC = NB * CTX, MALL = M + MC;
constexpr int NIN = 6656;
constexpr int FF = 4096;
constexpr int NCH = P / 64;
constexpr float EPS = 1e-6f;
constexpr float QSCALE = 0.08838834764831845f;

constexpr size_t MiB = 1u << 20;
constexpr size_t WS_CTL = 0, CTL_ZERO_BYTES = 1 * MiB;
constexpr size_t WS_MODX = 1 * MiB, WS_MODC = 1 * MiB + 128 * 1024, WS_ROPE = 1 * MiB + 192 * 1024;
constexpr size_t WS_GAM = 2 * MiB;
constexpr size_t WS_WIN = 4 * MiB, WS_WA = 18 * MiB, WS_WG = 20 * MiB, WS_WO = 22 * MiB, WS_W1 = 24 * MiB, WS_W2 = 32 * MiB;
constexpr size_t WS_QEB = 40 * MiB;
constexpr size_t WS_KA = 40 * MiB, WS_VA = WS_KA + (size_t)NB * P * 256 * 2, WS_GK = 57 * MiB, WS_GV = 74 * MiB, WS_LR = 108 * MiB;
constexpr size_t WS_QA = 111 * MiB, WS_GQ = 143 * MiB, WS_GO = 159 * MiB, WS_GA = 191 * MiB, WS_GG = 223 * MiB;
constexpr size_t WS_Y = 74 * MiB, WS_HN = 191 * MiB, WS_H = 40 * MiB;
static_assert(WS_VA + (size_t)NB * P * 256 * 2 <= WS_GK, "map");
constexpr size_t DO_OI = 0, DO_KDB = 32 * MiB, DO_AM = 49 * MiB;

typedef unsigned short bf16_t;
typedef short bf16x8 __attribute__((ext_vector_type(8)));
typedef float f32x4 __attribute__((ext_vector_type(4)));
typedef float f32x16 __attribute__((ext_vector_type(16)));
typedef unsigned u32x4 __attribute__((ext_vector_type(4)));
typedef unsigned u32x2 __attribute__((ext_vector_type(2)));

__device__ __forceinline__ unsigned f2bf(float f) { unsigned u = __builtin_bit_cast(unsigned, f); return (u + 0x7fffu + ((u >> 16) & 1u)) >> 16; }
__device__ __forceinline__ float bf2f(bf16_t h) { return __builtin_bit_cast(float, (unsigned)h << 16); }
__device__ __forceinline__ float bflo(unsigned w) { return __builtin_bit_cast(float, w << 16); }
__device__ __forceinline__ float bfhi(unsigned w) { return __builtin_bit_cast(float, w & 0xffff0000u); }
__device__ __forceinline__ float wave_sum(float v) {
#pragma unroll
    for (int o = 1; o < 64; o <<= 1) v += __shfl_xor(v, o);
    return v;
}
__device__ __forceinline__ float sigmoidf_(float x) { return __builtin_amdgcn_rcpf(1.f + __builtin_amdgcn_exp2f(-1.4426950408889634f * x)); }
__device__ __forceinline__ size_t prow(int m) {
    if (m < M) { const int b = m >> 12, t = m & 4095; return (size_t)b * P + CTX + t; }
    const int mc = m - M; const int b = mc >> 8, s = mc & 255; return (size_t)b * P + s;
}
__device__ __forceinline__ int crow(int r, int hi) { return (r & 3) + 8 * (r >> 2) + 4 * hi; }
__device__ __forceinline__ int win_src_col(int nd) {
    if (nd < 2048) return nd;
    if (nd < 6656) return nd + 32;
    if (nd < 6688) return 2048 + (nd - 6656);
    return -1;
}
namespace pg8 {
#define PG8_LAS __attribute__((address_space(3)))
typedef unsigned short bf16_t;
typedef short bf16x8 __attribute__((ext_vector_type(8)));
typedef float f32x4 __attribute__((ext_vector_type(4)));
typedef unsigned u32x4 __attribute__((ext_vector_type(4)));
constexpr int BM = 256, BK = 64, HALF = 128, HTB = HALF * BK * 2  , STAGE_BYTES = 8 * HTB, NXCD = 8, WGM = 8;

__host__ __device__ __forceinline__ int lds_byte(int r, int c) { const int st = (r >> 4) * 2 + (c >> 5), rr = r & 15, cc = c & 31, ob = rr * 64 + cc * 2; return st * 1024 + (ob ^ (((ob >> 9) & 1) << 5)); }
__host__ __device__ __forceinline__ void stage_rc(int b, int& R, int& C) { const int st = b / 1024, sb = b % 1024, swz = sb ^ (((sb >> 9) & 1) << 5); R = (st >> 1) * 16 + swz / 64; C = (st & 1) * 32 + (swz % 64) / 2; }
__host__ __device__ __forceinline__ int perm32(int rho) { const int n = rho >> 4, i = rho & 15; return 8 * (i >> 2) + 4 * n + (i & 3); }

struct Unit { int pm, pn; };
struct Gemm { const bf16_t* A; const bf16_t* Bt; int M, N, K; };

struct StaticOrder {
    int nM, nN, nwg, G, c;
    __host__ __device__ void init(int M, int N, int G_, int c_) { nM = M / BM; nN = N / BM; nwg = nM * nN; G = G_; c = c_; }
    __host__ __device__ bool next(int i, Unit& u) const {
        const long L = (long)i * G + c; if (L >= nwg) return false;
        int wgid = (int)L; { const int q = nwg / NXCD, r = nwg % NXCD, xcd = wgid % NXCD, off = wgid / NXCD; wgid = (xcd < r ? xcd * (q + 1) : r * (q + 1) + (xcd - r) * q) + off; }
        const int nig = WGM * nN, gid = wgid / nig, fm = gid * WGM, gsz = (nM - fm) < WGM ? (nM - fm) : WGM;
        u.pm = fm + ((wgid % nig) % gsz); u.pn = (wgid % nig) / gsz; return true;
    }
    __device__ __forceinline__ void a_ready(const Unit&) const {}
    __device__ __forceinline__ void done(const Unit&) const {}
};

__device__ __forceinline__ unsigned cvt_pk_bf16(float lo, float hi) { unsigned r; asm volatile("v_cvt_pk_bf16_f32 %0, %1, %2" : "=v"(r) : "v"(lo), "v"(hi)); return r; }
typedef float f32x2 __attribute__((ext_vector_type(2)));

__device__ __forceinline__ float sigm(float x) { return __builtin_amdgcn_rcpf(1.f + __builtin_amdgcn_exp2f(-1.4426950408889634f * x)); }
__device__ __forceinline__ float lo16(unsigned w) { return __builtin_bit_cast(float, w << 16); }
__device__ __forceinline__ float hi16(unsigned w) { return __builtin_bit_cast(float, w & 0xffff0000u); }
struct EpiInProj {
    static constexpr bool PERM = true, AFTER_DRAIN = false;
    bf16_t *KA, *VA, *GK, *GV, *QA, *GQ, *GO, *GA, *GG;
    __device__ __forceinline__ void operator()(const f32x4 (&acc)[2][2][4][2], const Unit& u, int wr, int wc, int fr, int fq) const {
        const int pn = u.pn; bf16_t* base; int ldc, colt; float sc = 1.f;
        size_t rowbase;
        if (u.pm < 64) { rowbase = pn < 8 ? (size_t)(u.pm >> 4) * 4352 + 256 + (size_t)(u.pm & 15) * 256 : (size_t)u.pm * 256; }
        else rowbase = (size_t)(u.pm - 64) * 4352;
        if (pn == 0) { base = KA; ldc = 256; colt = 0; }
        else if (pn == 1) { base = VA; ldc = 256; colt = 0; }
        else if (pn < 4) { base = GK; ldc = 512; colt = (pn - 2) * 256; }
        else if (pn < 8) { base = GV; ldc = 1024; colt = (pn - 4) * 256; }
        else if (pn < 12) { base = QA; ldc = 1024; colt = (pn - 8) * 256; }
        else if (pn < 14) { base = GQ; ldc = 512; colt = (pn - 12) * 256; sc = 0.08838834764831845f; }
        else if (pn < 18) { base = GO; ldc = 1024; colt = (pn - 14) * 256; }
        else if (pn < 22) { base = GA; ldc = 1024; colt = (pn - 18) * 256; }
        else { base = GG; ldc = 1024; colt = (pn - 22) * 256; }
        const int col0 = colt + wc * 32 + 8 * fq;
#pragma unroll
        for (int ai = 0; ai < 2; ++ai)
#pragma unroll
            for (int m = 0; m < 4; ++m) { bf16_t* rowp = base + (rowbase + (size_t)(ai * HALF + wr * 64 + m * 16 + fr)) * ldc + col0;
#pragma unroll
                for (int bj = 0; bj < 2; ++bj) { const f32x4 v0 = acc[ai][bj][m][0] * sc, v1 = acc[ai][bj][m][1] * sc;
                    u32x4 w; w.x = cvt_pk_bf16(v0[0], v0[1]); w.y = cvt_pk_bf16(v0[2], v0[3]); w.z = cvt_pk_bf16(v1[0], v1[1]); w.w = cvt_pk_bf16(v1[2], v1[3]);
                    *(u32x4*)(rowp + bj * HALF) = w; } }
    }
};
template <bool FIRST> struct EpiMerge {
    static constexpr bool PERM = true, AFTER_DRAIN = false;
    const bf16_t* G; bf16_t* Y;
    __device__ __forceinline__ void operator()(const f32x4 (&acc)[2][2][4][2], const Unit& u, int wr, int wc, int fr, int fq) const {
        const int row0 = u.pm * BM + wr * 64 + fr, col0 = u.pn * BM + wc * 32 + 8 * fq;
#pragma unroll
        for (int ai = 0; ai < 2; ++ai)
#pragma unroll
            for (int m = 0; m < 4; ++m) { const size_t off = (size_t)(row0 + ai * HALF + m * 16) * 1024 + col0;
#pragma unroll
                for (int bj = 0; bj < 2; ++bj) { const u32x4 g = *(const u32x4*)(G + off + bj * HALF);
                    f32x4 v0 = acc[ai][bj][m][0], v1 = acc[ai][bj][m][1];
                    v0[0] *= sigm(lo16(g.x)); v0[1] *= sigm(hi16(g.x)); v0[2] *= sigm(lo16(g.y)); v0[3] *= sigm(hi16(g.y));
                    v1[0] *= sigm(lo16(g.z)); v1[1] *= sigm(hi16(g.z)); v1[2] *= sigm(lo16(g.w)); v1[3] *= sigm(hi16(g.w));
                    if (!FIRST) { const u32x4 y = *(const u32x4*)(Y + off + bj * HALF);
                        v0[0] += lo16(y.x); v0[1] += hi16(y.x); v0[2] += lo16(y.y); v0[3] += hi16(y.y); v1[0] += lo16(y.z); v1[1] += hi16(y.z); v1[2] += lo16(y.w); v1[3] += hi16(y.w); }
                    u32x4 w; w.x = cvt_pk_bf16(v0[0], v0[1]); w.y = cvt_pk_bf16(v0[2], v0[3]); w.z = cvt_pk_bf16(v1[0], v1[1]); w.w = cvt_pk_bf16(v1[2], v1[3]);
                    *(u32x4*)(Y + off + bj * HALF) = w; } }
    }
};
struct EpiGateRes {
    static constexpr bool PERM = false, AFTER_DRAIN = false;
    const float* base; float* out; const float* gate;
    __device__ __forceinline__ void operator()(const f32x4 (&acc)[2][2][4][2], const Unit& u, int wr, int wc, int fr, int fq) const {
        const int row0 = u.pm * BM + wr * 64 + fr, col0 = u.pn * BM + wc * 32 + 4 * fq;
        const float* gp = gate + (size_t)(u.pm >> 4) * 6144 + col0;
        f32x4 gv[2][2];
#pragma unroll
        for (int bj = 0; bj < 2; ++bj)
#pragma unroll
            for (int n = 0; n < 2; ++n) gv[bj][n] = *(const f32x4*)(gp + bj * HALF + n * 16);
#pragma unroll
        for (int ai = 0; ai < 2; ++ai)
#pragma unroll
            for (int m = 0; m < 4; ++m) { const size_t off = (size_t)(row0 + ai * HALF + m * 16) * 1024 + col0;
#pragma unroll
                for (int bj = 0; bj < 2; ++bj)
#pragma unroll
                    for (int n = 0; n < 2; ++n) { const f32x4 b = *(const f32x4*)(base + off + bj * HALF + n * 16);
                        *(f32x4*)(out + off + bj * HALF + n * 16) = b + gv[bj][n] * acc[ai][bj][m][n]; } }
    }
};
struct EpiSqRelu {
    static constexpr bool PERM = true, AFTER_DRAIN = false;
    bf16_t* H;
    __device__ __forceinline__ void operator()(const f32x4 (&acc)[2][2][4][2], const Unit& u, int wr, int wc, int fr, int fq) const {
        const int row0 = u.pm * BM + wr * 64 + fr, col0 = u.pn * BM + wc * 32 + 8 * fq;
#pragma unroll
        for (int ai = 0; ai < 2; ++ai)
#pragma unroll
            for (int m = 0; m < 4; ++m) { bf16_t* rowp = H + (size_t)(row0 + ai * HALF + m * 16) * 4096 + col0;
#pragma unroll
                for (int bj = 0; bj < 2; ++bj) { f32x4 v0 = acc[ai][bj][m][0], v1 = acc[ai][bj][m][1];
#pragma unroll
                    for (int e = 0; e < 4; ++e) { const float a = __builtin_fmaxf(v0[e], 0.f), b = __builtin_fmaxf(v1[e], 0.f); v0[e] = a * a; v1[e] = b * b; }
                    u32x4 w; w.x = cvt_pk_bf16(v0[0], v0[1]); w.y = cvt_pk_bf16(v0[2], v0[3]); w.z = cvt_pk_bf16(v1[0], v1[1]); w.w = cvt_pk_bf16(v1[2], v1[3]);
                    *(u32x4*)(rowp + bj * HALF) = w; } }
    }
};
struct InOrder {
    StaticOrder so;
    __device__ void init(int G_, int c_) { so.init(16384, 6656, G_, c_); }
    __device__ bool next(int i, Unit& u) const {
        const int L = i * so.G + so.c; if (L >= 1696) return false;
        if (L < 1664) return so.next(i, u);
        const int e = L - 1664; u.pm = 64 + (e >> 3); u.pn = e & 7; return true;
    }
    __device__ __forceinline__ void a_ready(const Unit&) const {}
    __device__ __forceinline__ void done(const Unit&) const {}
};

template <class Epi, class Sched, bool ALIGN_EPI = false, bool SP2 = false>
__device__ __forceinline__ void gemm_phase(PG8_LAS unsigned char* lds, const Gemm g, const Sched& S, const Epi& E) {
    const int tid = threadIdx.x, wid = __builtin_amdgcn_readfirstlane(tid >> 6), lane = tid & 63, wr = wid >> 2, wc = wid & 3, fr = lane & 15, fq = lane >> 4;
    const int K = g.K, nt = K / BK;
    unsigned voffA[2], voffB[2];
#pragma unroll
    for (int i = 0; i < 2; ++i) { int R, C; stage_rc(tid * 16 + i * 8192, R, C); const int Rb = Epi::PERM ? ((R & ~31) + perm32(R & 31)) : R;
        voffA[i] = (unsigned)(R * K + C) * 2u; voffB[i] = (unsigned)(Rb * K + C) * 2u; }
    const size_t kstep = (size_t)(BK * 2);
    const size_t hstep = (size_t)HALF * K * 2;
    const size_t tstep = 2 * hstep;
    const unsigned ldsw = (unsigned)wid * 1024u;
    const int aoff = lds_byte(wr * 64 + fr, fq * 8), boff = lds_byte(wc * 32 + fr, fq * 8);
#define PG8_SA(b, h) (((b) * 2 + (h)) * HTB)
#define PG8_SB(b, h) ((4 + (b) * 2 + (h)) * HTB)
#define PG8_STAGE(bufoff, gbase, voff) do { _Pragma("unroll") for (int _i = 0; _i < 2; ++_i) \
        __builtin_amdgcn_global_load_lds((const unsigned*)((const char*)(gbase) + (voff)[_i]), (PG8_LAS unsigned*)(lds + (bufoff) + ldsw + _i * 8192), 16, 0, 0); } while (0)
#define PG8_LDA(dst, b, h) do { _Pragma("unroll") for (int m = 0; m < 4; ++m) _Pragma("unroll") for (int k = 0; k < 2; ++k) dst[m][k] = *(const PG8_LAS bf16x8*)(lds + PG8_SA(b, h) + aoff + m * 2048 + k * 1024); } while (0)
#define PG8_LDB(dst, b, h) do { _Pragma("unroll") for (int n = 0; n < 2; ++n) _Pragma("unroll") for (int k = 0; k < 2; ++k) dst[n][k] = *(const PG8_LAS bf16x8*)(lds + PG8_SB(b, h) + boff + n * 2048 + k * 1024); } while (0)
#define PG8_MMA(ai, bj, At, Bt) do { __builtin_amdgcn_s_setprio(1); _Pragma("unroll") for (int m = 0; m < 4; ++m) _Pragma("unroll") for (int n = 0; n < 2; ++n) _Pragma("unroll") for (int k = 0; k < 2; ++k) \
        acc[ai][bj][m][n] = __builtin_amdgcn_mfma_f32_16x16x32_bf16(Bt[n][k], At[m][k], acc[ai][bj][m][n], 0, 0, 0); __builtin_amdgcn_s_setprio(0); } while (0)
#define PG8_WAIT_V(n) asm volatile("s_waitcnt vmcnt(" #n ")" ::: "memory")
#define PG8_WAIT_L(n) asm volatile("s_waitcnt lgkmcnt(" #n ")" ::: "memory")
#define PG8_BAR __builtin_amdgcn_s_barrier()
#define PG8_SCHED __builtin_amdgcn_sched_barrier(0)
    Unit cur, nxt; int ui = 0;
    if (!S.next(0, cur)) return;
    f32x4 acc[2][2][4][2];
#pragma unroll
    for (int a = 0; a < 2; ++a)
#pragma unroll
        for (int b = 0; b < 2; ++b)
#pragma unroll
            for (int m = 0; m < 4; ++m)
#pragma unroll
                for (int n = 0; n < 2; ++n) acc[a][b][m][n] = (f32x4){0.f, 0.f, 0.f, 0.f};
    bf16x8 At[4][2], B0[2][2], B1[2][2];
    const char* cA = (const char*)g.A + (size_t)cur.pm * tstep; const char* cB = (const char*)g.Bt + (size_t)cur.pn * tstep;
    S.a_ready(cur);
    if constexpr (SP2) {
        PG8_STAGE(PG8_SB(0, 0), cB, voffB); PG8_STAGE(PG8_SB(0, 1), cB + hstep, voffB); PG8_STAGE(PG8_SA(0, 0), cA, voffA); PG8_STAGE(PG8_SA(0, 1), cA + hstep, voffA);
        if (wr == 1) PG8_BAR;
        PG8_WAIT_V(2); PG8_BAR;
        PG8_STAGE(PG8_SB(1, 0), cB + kstep, voffB); PG8_STAGE(PG8_SA(1, 0), cA + kstep, voffA); PG8_STAGE(PG8_SB(1, 1), cB + hstep + kstep, voffB);
        PG8_WAIT_V(6); PG8_BAR;
    } else {
        PG8_STAGE(PG8_SB(0, 0), cB, voffB); PG8_STAGE(PG8_SA(0, 0), cA, voffA); PG8_STAGE(PG8_SB(0, 1), cB + hstep, voffB); PG8_STAGE(PG8_SA(0, 1), cA + hstep, voffA);
        if (wr == 1) PG8_BAR;
        PG8_WAIT_V(4); PG8_BAR;
        PG8_STAGE(PG8_SB(1, 0), cB + kstep, voffB); PG8_STAGE(PG8_SA(1, 0), cA + kstep, voffA); PG8_STAGE(PG8_SB(1, 1), cB + hstep + kstep, voffB);
        PG8_WAIT_V(6); PG8_BAR;
    }
    for (;;) {
        const bool has_next = S.next(ui + 1, nxt);
        const char* nA = has_next ? (const char*)g.A + (size_t)nxt.pm * tstep : cA; const char* nB = has_next ? (const char*)g.Bt + (size_t)nxt.pn * tstep : cB;
        for (int t = 0; t < nt; t += 2) {
            const bool last = (t == nt - 2);
            const char* a1 = cA + (size_t)(t + 1) * kstep;
            const char* a2 = last ? nA : cA + (size_t)(t + 2) * kstep; const char* b2 = last ? nB : cB + (size_t)(t + 2) * kstep;
            const char* a3 = a2 + kstep; const char* b3 = b2 + kstep;
            if (last && has_next) S.a_ready(nxt);
            if constexpr (SP2) {
            PG8_LDB(B0, 0, 0); PG8_LDB(B1, 0, 1); PG8_SCHED; PG8_LDA(At, 0, 0); PG8_STAGE(PG8_SA(1, 1), a1 + hstep, voffA);
            PG8_WAIT_V(8); PG8_WAIT_L(0); PG8_BAR; PG8_MMA(0, 0, At, B0); PG8_MMA(0, 1, At, B1); PG8_BAR; PG8_SCHED;
            PG8_LDA(At, 0, 1); PG8_STAGE(PG8_SB(0, 0), b2, voffB); PG8_STAGE(PG8_SB(0, 1), b2 + hstep, voffB); PG8_STAGE(PG8_SA(0, 0), a2, voffA);
            PG8_WAIT_V(8); PG8_WAIT_L(0); PG8_BAR; PG8_MMA(1, 0, At, B0); PG8_MMA(1, 1, At, B1); PG8_BAR; PG8_SCHED;
            PG8_LDB(B0, 1, 0); PG8_LDB(B1, 1, 1); PG8_SCHED; PG8_LDA(At, 1, 0); PG8_STAGE(PG8_SA(0, 1), a2 + hstep, voffA);
            PG8_WAIT_V(8); PG8_WAIT_L(0); PG8_BAR; PG8_MMA(0, 0, At, B0); PG8_MMA(0, 1, At, B1); PG8_BAR; PG8_SCHED;
            PG8_LDA(At, 1, 1); PG8_STAGE(PG8_SB(1, 0), b3, voffB); PG8_STAGE(PG8_SB(1, 1), b3 + hstep, voffB); PG8_STAGE(PG8_SA(1, 0), a3, voffA);
            PG8_WAIT_V(8); PG8_WAIT_L(0); PG8_BAR; PG8_MMA(1, 0, At, B0); PG8_MMA(1, 1, At, B1); PG8_BAR; PG8_SCHED;
            } else {
            PG8_LDB(B0, 0, 0); PG8_SCHED; PG8_LDA(At, 0, 0); PG8_STAGE(PG8_SA(1, 1), a1 + hstep, voffA);
            PG8_WAIT_L(8); PG8_BAR; PG8_WAIT_L(0); PG8_MMA(0, 0, At, B0); PG8_BAR; PG8_SCHED;
            PG8_LDB(B1, 0, 1); PG8_STAGE(PG8_SB(0, 0), b2, voffB);
            PG8_BAR; PG8_WAIT_L(0); PG8_MMA(0, 1, At, B1); PG8_BAR;
            PG8_LDA(At, 0, 1); PG8_STAGE(PG8_SA(0, 0), a2, voffA);
            PG8_BAR; PG8_WAIT_L(0); PG8_MMA(1, 0, At, B0); PG8_BAR; PG8_SCHED;
            PG8_STAGE(PG8_SB(0, 1), b2 + hstep, voffB);
            PG8_WAIT_V(6); PG8_BAR; PG8_MMA(1, 1, At, B1); PG8_BAR;
            PG8_LDB(B0, 1, 0); PG8_SCHED; PG8_LDA(At, 1, 0); PG8_STAGE(PG8_SA(0, 1), a2 + hstep, voffA);
            PG8_WAIT_L(8); PG8_BAR; PG8_WAIT_L(0); PG8_MMA(0, 0, At, B0); PG8_BAR; PG8_SCHED;
            PG8_LDB(B1, 1, 1); PG8_STAGE(PG8_SB(1, 0), b3, voffB);
            PG8_BAR; PG8_WAIT_L(0); PG8_MMA(0, 1, At, B1); PG8_BAR;
            PG8_LDA(At, 1, 1); PG8_STAGE(PG8_SA(1, 0), a3, voffA);
            PG8_BAR; PG8_WAIT_L(0); PG8_MMA(1, 0, At, B0); PG8_BAR; PG8_SCHED;
            PG8_STAGE(PG8_SB(1, 1), b3 + hstep, voffB);
            PG8_WAIT_V(6); PG8_BAR; PG8_MMA(1, 1, At, B1); PG8_BAR;
            }
        }
        if constexpr (ALIGN_EPI) { if (wr == 0) PG8_BAR; }
        if constexpr (!Epi::AFTER_DRAIN) { E(acc, cur, wr, wc, fr, fq); S.done(cur); }
        if (!has_next) break;
#pragma unroll
        for (int a = 0; a < 2; ++a)
#pragma unroll
            for (int b = 0; b < 2; ++b)
#pragma unroll
                for (int m = 0; m < 4; ++m)
#pragma unroll
                    for (int n = 0; n < 2; ++n) acc[a][b][m][n] = (f32x4){0.f, 0.f, 0.f, 0.f};
        cur = nxt; cA = nA; cB = nB; ++ui;
        if constexpr (ALIGN_EPI) { if (wr == 1) PG8_BAR; }
    }
    PG8_WAIT_V(0);
    if constexpr (!ALIGN_EPI) { if (wr == 0) PG8_BAR; }
    PG8_BAR;
    if constexpr (Epi::AFTER_DRAIN) { E.fused(acc, cur, wr, wc, fr, fq, lds, wid, lane); S.done(cur); }
#undef PG8_SA
#undef PG8_SB
#undef PG8_STAGE
#undef PG8_LDA
#undef PG8_LDB
#undef PG8_MMA
#undef PG8_WAIT_V
#undef PG8_WAIT_L
#undef PG8_BAR
#undef PG8_SCHED
}
}
#define GAS __attribute__((address_space(1)))
#define LAS __attribute__((address_space(3)))
typedef unsigned short bf16;
typedef unsigned v4u __attribute__((ext_vector_type(4)));
typedef float f32x4 __attribute__((ext_vector_type(4)));
typedef short bf16x8 __attribute__((ext_vector_type(8)));
typedef GAS unsigned gu32;
typedef GAS unsigned long long gu64;
#define RLX_AGENT __ATOMIC_RELAXED, __HIP_MEMORY_SCOPE_AGENT
#define LDS_WAIT() asm volatile("s_waitcnt lgkmcnt(0)" ::: "memory")
#define VM_WAIT() asm volatile("s_waitcnt vmcnt(0)" ::: "memory")
__device__ __forceinline__ unsigned long long rt() { return __builtin_amdgcn_s_memrealtime(); }
__device__ __forceinline__ unsigned pk2(float lo, float hi) { return f2bf(lo) | (f2bf(hi) << 16); }

#define XB_TMO      128
#define XB_XCNT(j)  (256  + 64 * (j))
#define XB_XSUB(j)  (1280 + 64 * (j))
#define XB_XGEN(j)  (2304 + 64 * (j))
#define XB_TOP      3328
#define XB_TOPGEN   3392
#define XCD_BAR_WORDS 3456
#define XB_SPIN_CAP (1u << 18)

__device__ __forceinline__ unsigned xb_ld(unsigned* p)              { return __hip_atomic_load(p, __ATOMIC_RELAXED, __HIP_MEMORY_SCOPE_AGENT); }
__device__ __forceinline__ unsigned xb_add(unsigned* p, unsigned v) { return __hip_atomic_fetch_add(p, v, __ATOMIC_RELAXED, __HIP_MEMORY_SCOPE_AGENT); }
__device__ __forceinline__ unsigned xb_xcc_id() { return (unsigned)__builtin_amdgcn_s_getreg((3 << 11) | 20) & 0xFu; }
#define XB_SPIN(cond, bar) do { unsigned _sp = 0; while (cond) { __builtin_amdgcn_s_sleep(1); \
    if ((++_sp & 255u) == 0u) { if (xb_ld(&(bar)[XB_TMO])) break; if (_sp > XB_SPIN_CAP) { atomicAdd(&(bar)[XB_TMO], 1u); break; } } } } while (0)

struct XcdBarrier {
    unsigned* bar; unsigned x;
    volatile LAS unsigned* st;
};

__device__ __forceinline__ XcdBarrier xcd_barrier_post(unsigned* bar, volatile LAS unsigned* st) {
    XcdBarrier b; b.bar = bar; b.x = xb_xcc_id(); b.st = st;
    if (threadIdx.x == 0) (void)xb_add(&bar[XB_XCNT(b.x)], 1u);
    return b;
}
__device__ __forceinline__ void xcd_barrier_complete(unsigned* bar, unsigned x, unsigned& nloc, unsigned& nx) {
    const unsigned G = gridDim.x * gridDim.y * gridDim.z;
    unsigned sum, cnt, mine, sp = 0u;
    for (;;) {
        sum = 0u; cnt = 0u; mine = 0u;
#pragma unroll
        for (unsigned j = 0; j < 16; ++j) { const unsigned c = xb_ld(&bar[XB_XCNT(j)]); sum += c; cnt += (c > 0u) ? 1u : 0u; mine = (j == x) ? c : mine; }
        if (sum == G) break;
        __builtin_amdgcn_s_sleep(1);
        if ((++sp & 255u) == 0u) { if (xb_ld(&bar[XB_TMO])) break; if (sp > XB_SPIN_CAP) { atomicAdd(&bar[XB_TMO], 1u); break; } }
    }
    nloc = mine > 0u ? mine : 1u; nx = cnt > 0u ? cnt : 1u;
}

__device__ __forceinline__ void xcd_barrier(const XcdBarrier& b) {
    asm volatile("s_waitcnt vmcnt(0)" ::: "memory");
    __syncthreads();
    if (threadIdx.x == 0) {
        unsigned* bar = b.bar;
        __builtin_amdgcn_s_waitcnt(0);
        unsigned nloc = b.st[0], nx = b.st[1];
        if (nloc == 0u) { xcd_barrier_complete(bar, b.x, nloc, nx); b.st[0] = nloc; b.st[1] = nx; }
        const unsigned old = xb_add(&bar[XB_XSUB(b.x)], 1u);
        const unsigned gen = old / nloc;
        if (old + 1u == (gen + 1u) * nloc) {
            __builtin_amdgcn_fence(__ATOMIC_RELEASE, "agent");
            asm volatile("s_waitcnt vmcnt(0)" ::: "memory");
            const unsigned og = xb_add(&bar[XB_TOP], 1u);
            const unsigned tg = og / nx;
            if (og + 1u == (tg + 1u) * nx) xb_add(&bar[XB_TOPGEN], 1u);
            else XB_SPIN(xb_ld(&bar[XB_TOPGEN]) == tg, bar);
            __builtin_amdgcn_fence(__ATOMIC_ACQUIRE, "agent");
            xb_add(&bar[XB_XGEN(b.x)], 1u);
            asm volatile("s_waitcnt vmcnt(0)" ::: "memory");
        } else {
            XB_SPIN(xb_ld(&bar[XB_XGEN(b.x)]) == gen, bar);
            __builtin_amdgcn_fence(__ATOMIC_ACQUIRE, "agent");
            asm volatile("s_waitcnt vmcnt(0)" ::: "memory");
        }
    }
    __syncthreads();
}

namespace att {
using bf16 = unsigned short;
constexpr int   D = 128, NW = 8, QBLK = 32, KVBLK = 64;
constexpr float SCALE = 0.088388347648318440f;
constexpr float THR = 8.f;
constexpr int SDEPTH = 2;
constexpr int LDQ = 1024, LDK = 256, LDO = 1024;
constexpr size_t SHM_V = KVBLK * D * 2, SHM_K = KVBLK * D * 2, SHM_ATTN = 2 * SHM_V + 2 * SHM_K + NW * 64 * 4;
using s16x4  = __attribute__((ext_vector_type(4))) short;
using f32x8  = __attribute__((ext_vector_type(8))) float;
using bf16x8 = __attribute__((ext_vector_type(8))) short;
using s16x4  = __attribute__((ext_vector_type(4))) short;
using f32x16 = __attribute__((ext_vector_type(16))) float;
using f32x8  = __attribute__((ext_vector_type(8))) float;
using u32x4  = __attribute__((ext_vector_type(4))) unsigned;
#define KSWZ(row, colB) ((row) * 256 + ((colB) ^ (((row) & 7) << 4)))
#define SBAR() __builtin_amdgcn_sched_barrier(0)
__device__ __forceinline__ unsigned cvtpk(float lo, float hi) {
  unsigned r; asm volatile("v_cvt_pk_bf16_f32 %0, %1, %2" : "=v"(r) : "v"(lo), "v"(hi)); return r;
}
template <typename TIn> struct Stage;
template <> struct Stage<bf16>  { using T = bf16x8;
  __device__ static __forceinline__ T ld8(const bf16* p) { return *reinterpret_cast<const bf16x8*>(p); }
  __device__ static __forceinline__ bf16x8 tobf(T x) { return x; } };
__device__ __forceinline__ void partialSM(f32x16& p0, f32x16& p1, float& m_reg, float& mn, float& alpha) {
  constexpr float C = SCALE * 1.4426950408889634f;
  float pmax = p0[0]; for (int r = 1; r < 16; ++r) pmax = fmaxf(pmax, p0[r]); for (int r = 0; r < 16; ++r) pmax = fmaxf(pmax, p1[r]);
  { auto rr = __builtin_amdgcn_permlane32_swap(__float_as_uint(pmax), __float_as_uint(pmax), false, false);
    pmax = fmaxf(__uint_as_float(rr[0]), __uint_as_float(rr[1])); }
  if (__builtin_expect(__all(pmax - m_reg <= THR / SCALE), 1)) { mn = m_reg; alpha = 1.f; }
  else { mn = fmaxf(m_reg, pmax); alpha = __builtin_amdgcn_exp2f((m_reg - mn) * C); m_reg = mn; }
  float mnC = -mn * C;
  for (int r = 0; r < 16; ++r) p0[r] = fmaf(p0[r], C, mnC); for (int r = 0; r < 16; ++r) p1[r] = fmaf(p1[r], C, mnC);
  for (int r = 0; r < 16; ++r) p0[r] = __builtin_amdgcn_exp2f(p0[r]);
}
__device__ __forceinline__ void finishSM(f32x16& p0, f32x16& p1, float alpha, float& l_reg, bf16x8& pa0, bf16x8& pa1, bf16x8& pa2, bf16x8& pa3) {
  for (int r = 0; r < 16; ++r) p1[r] = __builtin_amdgcn_exp2f(p1[r]);
  float ps = 0; for (int r = 0; r < 16; ++r) ps += p0[r]; for (int r = 0; r < 16; ++r) ps += p1[r];
  { auto rr = __builtin_amdgcn_permlane32_swap(__float_as_uint(ps), __float_as_uint(ps), false, false);
    ps = __uint_as_float(rr[0]) + __uint_as_float(rr[1]); }
  l_reg = l_reg * alpha + ps;
#define PK4(P, BASE, OUT) do { unsigned a0 = cvtpk(P[BASE + 0], P[BASE + 1]), a1 = cvtpk(P[BASE + 2], P[BASE + 3]);   \
    unsigned b0 = cvtpk(P[BASE + 4], P[BASE + 5]), b1 = cvtpk(P[BASE + 6], P[BASE + 7]);                              \
    auto r0 = __builtin_amdgcn_permlane32_swap(a0, b0, false, false); auto r1 = __builtin_amdgcn_permlane32_swap(a1, b1, false, false); \
    u32x4 w = {r0[0], r1[0], r0[1], r1[1]}; OUT = *reinterpret_cast<bf16x8*>(&w); } while (0)
  PK4(p0, 0, pa0); PK4(p0, 8, pa1); PK4(p1, 0, pa2); PK4(p1, 8, pa3);
#undef PK4
}
__device__ __forceinline__ void qkt(f32x16& p0, f32x16& p1, const bf16* Ks, const bf16x8* qr, int r32, int hi) {
  p0 = f32x16{}; p1 = f32x16{};
  for (int d0 = 0; d0 < 8; ++d0) { int cb = (d0 * 16 + hi * 8) * 2;
    bf16x8 b0 = *reinterpret_cast<const bf16x8*>((const char*)Ks + KSWZ(r32, cb));
    bf16x8 b1 = *reinterpret_cast<const bf16x8*>((const char*)Ks + KSWZ(32 + r32, cb));
    p0 = __builtin_amdgcn_mfma_f32_32x32x16_bf16(b0, qr[d0], p0, 0, 0, 0);
    p1 = __builtin_amdgcn_mfma_f32_32x32x16_bf16(b1, qr[d0], p1, 0, 0, 0); }
}
__device__ __forceinline__ int v_st(int k, int c) { const int kk = (k & ~0xC) | ((k & 4) << 1) | ((k & 8) >> 1); return ((kk >> 3) * 4 + (c >> 5)) * 512 + ((kk & 7) * 32 + (c & 31)) * 2; }
__device__ __forceinline__ int v_rd_base(int lane) { return ((lane & 3) << 3) | (((lane >> 2) & 3) << 6) | (((lane >> 4) & 1) << 5) | (((lane >> 5) & 1) << 8); }
constexpr int v_rd_off(int d0, int ks, int half) { return d0 * 512 + ks * 4096 + half * 2048; }
template <int OFF> __device__ __forceinline__ s16x4 tr_read(int vb) {
  s16x4 r; asm volatile("ds_read_b64_tr_b16 %0, %1 offset:%2" : "=&v"(r) : "v"(vb), "i"(OFF) : "memory"); return r;
}
template <int D0> __device__ __forceinline__ void pv_one(f32x16& od, int vb, bf16x8 pa0, bf16x8 pa1, bf16x8 pa2, bf16x8 pa3) {
  const s16x4 l0 = tr_read<v_rd_off(D0, 0, 0)>(vb), h0 = tr_read<v_rd_off(D0, 0, 1)>(vb), l1 = tr_read<v_rd_off(D0, 1, 0)>(vb), h1 = tr_read<v_rd_off(D0, 1, 1)>(vb);
  const s16x4 l2 = tr_read<v_rd_off(D0, 2, 0)>(vb), h2 = tr_read<v_rd_off(D0, 2, 1)>(vb), l3 = tr_read<v_rd_off(D0, 3, 0)>(vb), h3 = tr_read<v_rd_off(D0, 3, 1)>(vb);
  asm volatile("s_waitcnt lgkmcnt(0)" ::: "memory"); SBAR();
#define PK(L, H) (bf16x8){L[0], L[1], L[2], L[3], H[0], H[1], H[2], H[3]}
  od = __builtin_amdgcn_mfma_f32_32x32x16_bf16(pa0, PK(l0, h0), od, 0, 0, 0);
  od = __builtin_amdgcn_mfma_f32_32x32x16_bf16(pa1, PK(l1, h1), od, 0, 0, 0);
  od = __builtin_amdgcn_mfma_f32_32x32x16_bf16(pa2, PK(l2, h2), od, 0, 0, 0);
  od = __builtin_amdgcn_mfma_f32_32x32x16_bf16(pa3, PK(l3, h3), od, 0, 0, 0);
#undef PK
}
__device__ __forceinline__ void pv_d0(f32x16* o, int vb, bf16x8 pa0, bf16x8 pa1, bf16x8 pa2, bf16x8 pa3) {
  pv_one<0>(o[0], vb, pa0, pa1, pa2, pa3); pv_one<1>(o[1], vb, pa0, pa1, pa2, pa3); pv_one<2>(o[2], vb, pa0, pa1, pa2, pa3); pv_one<3>(o[3], vb, pa0, pa1, pa2, pa3);
}

template <typename TQ>
__device__ __forceinline__ void attn_dense_body(const TQ* Qb, const bf16* __restrict__ Kh, const bf16* __restrict__ Vh,
                                                bf16* Ob, int seq, char* lds) {
  using St = Stage<bf16>; using SQ = Stage<TQ>;
  const int tid = threadIdx.x, wid = tid >> 6, lane = tid & 63, r32 = lane & 31, hi = lane >> 5;
  bf16* V_lds = (bf16*)lds; bf16* K_lds = (bf16*)(lds + 2 * SHM_V);
  float* ws = (float*)(lds + 2 * SHM_V + 2 * SHM_K) + wid * 64; float* li_l = ws; float* al_l = ws + 32;
  float m_reg = -1e30f, l_reg = 0; f32x16 o[4] = {}; bf16x8 qr[8];
  const TQ* Qw = Qb + (long)(wid * QBLK + r32) * LDQ + hi * 8;
#pragma unroll
  for (int d0 = 0; d0 < 8; ++d0) qr[d0] = SQ::tobf(SQ::ld8(Qw + d0 * 16));
  const int sr = tid >> 4, sc = (tid & 15) * 8, vst0 = v_st(sr, sc), vst1 = v_st(32 + sr, sc);
  const int vb0 = (int)(uintptr_t)V_lds + v_rd_base(lane);
  struct { typename St::T vs0, vs1, ks0, ks1; } sr_[SDEPTH];
#define SLOAD(i, k0) do { sr_[i].vs0 = St::ld8(&Vh[(long)((k0) + sr) * LDK + sc]); sr_[i].vs1 = St::ld8(&Vh[(long)((k0) + 32 + sr) * LDK + sc]); \
    sr_[i].ks0 = St::ld8(&Kh[(long)((k0) + sr) * LDK + sc]); sr_[i].ks1 = St::ld8(&Kh[(long)((k0) + 32 + sr) * LDK + sc]); } while (0)
#define SWRITE(b, i) do { *(bf16x8*)((char*)V_lds + (b) * SHM_V + vst0) = St::tobf(sr_[i].vs0);          \
    *(bf16x8*)((char*)V_lds + (b) * SHM_V + vst1) = St::tobf(sr_[i].vs1); int kc = sc * 2;               \
    *(bf16x8*)((char*)K_lds + (b) * SHM_K + KSWZ(sr, kc)) = St::tobf(sr_[i].ks0);                       \
    *(bf16x8*)((char*)K_lds + (b) * SHM_K + KSWZ(32 + sr, kc)) = St::tobf(sr_[i].ks1); } while (0)
#define SWAIT() do { if constexpr (SDEPTH == 2) asm volatile("s_waitcnt vmcnt(4)" ::: "memory"); else asm volatile("s_waitcnt vmcnt(0)" ::: "memory"); } while (0)
#define RESC(a) do { if (__any((a) < 1.f)) { if (hi == 0) al_l[r32] = (a); asm volatile("s_waitcnt lgkmcnt(0)" ::: "memory"); \
    for (int d = 0; d < 4; ++d) for (int r = 0; r < 16; ++r) o[d][r] *= al_l[crow(r, hi)]; } } while (0)
  f32x16 pA0, pA1, pB0, pB1; float mnA, mnB, alA, alB; bf16x8 pa0, pa1, pa2, pa3; const int NT = seq / KVBLK;
  constexpr int SE = 0, SO = SDEPTH - 1;
  SLOAD(SE, 0); asm volatile("s_waitcnt vmcnt(0)" ::: "memory"); SWRITE(0, SE); __syncthreads();
  qkt(pA0, pA1, K_lds, qr, r32, hi); partialSM(pA0, pA1, m_reg, mnA, alA);
  SLOAD(SO, KVBLK); if constexpr (SDEPTH == 2) { if (2 < NT) SLOAD(SE, 2 * KVBLK); }
  SWAIT(); SWRITE(1, SO); __syncthreads();
  for (int j = 1; j + 1 < NT; j += 2) {
    SBAR(); qkt(pB0, pB1, (bf16*)((char*)K_lds + SHM_K), qr, r32, hi);
    finishSM(pA0, pA1, alA, l_reg, pa0, pa1, pa2, pa3); SBAR();
    SLOAD(SO, (j + SDEPTH) * KVBLK); SBAR();
    pv_d0(o, vb0, pa0, pa1, pa2, pa3); partialSM(pB0, pB1, m_reg, mnB, alB);
    __syncthreads(); SWAIT(); SWRITE(0, SE);
    RESC(alB); __syncthreads();
    SBAR(); qkt(pA0, pA1, K_lds, qr, r32, hi);
    finishSM(pB0, pB1, alB, l_reg, pa0, pa1, pa2, pa3); SBAR();
    if (SDEPTH == 1 || j + 3 < NT) SLOAD(SE, (j + 1 + SDEPTH) * KVBLK); SBAR();
    pv_d0(o, vb0 + (int)SHM_V, pa0, pa1, pa2, pa3); partialSM(pA0, pA1, m_reg, mnA, alA);
    __syncthreads(); SWAIT(); SWRITE(1, SO);
    RESC(alA); __syncthreads();
  }
  SBAR(); qkt(pB0, pB1, (bf16*)((char*)K_lds + SHM_K), qr, r32, hi);
  finishSM(pA0, pA1, alA, l_reg, pa0, pa1, pa2, pa3); SBAR();
  pv_d0(o, vb0, pa0, pa1, pa2, pa3); partialSM(pB0, pB1, m_reg, mnB, alB);
  __syncthreads(); RESC(alB);
  finishSM(pB0, pB1, alB, l_reg, pa0, pa1, pa2, pa3); SBAR();
  pv_d0(o, vb0 + (int)SHM_V, pa0, pa1, pa2, pa3);
  if (hi == 0) li_l[r32] = l_reg; asm volatile("s_waitcnt lgkmcnt(0)" ::: "memory");
  float rli[16];
#pragma unroll
  for (int r = 0; r < 16; ++r) rli[r] = __builtin_amdgcn_rcpf(li_l[crow(r, hi)]);
  bf16* Ow = Ob + (long)(wid * QBLK) * LDO;
#pragma unroll
  for (int r = 0; r < 16; ++r) { int orow = crow(r, hi);
#pragma unroll
    for (int d0 = 0; d0 < 4; ++d0) Ow[(long)orow * LDO + d0 * 32 + r32] = (bf16)f2bf(o[d0][r] * rli[r]); }
  __syncthreads();
#undef SLOAD
#undef SWRITE
#undef SWAIT
#undef RESC
}
#undef KSWZ
#undef SBAR
}

namespace gla {
typedef __attribute__((address_space(3))) unsigned char* lptr;
typedef __attribute__((address_space(3))) const char* lds_cptr;
typedef short v4i16_t __attribute__((ext_vector_type(4)));
typedef short s16x4 __attribute__((ext_vector_type(4)));
__device__ __forceinline__ s16x4 vtr(lds_cptr p) { return __builtin_bit_cast(s16x4, __builtin_amdgcn_ds_read_tr16_b64_v4i16((__attribute__((address_space(3))) v4i16_t*)p)); }
__device__ __forceinline__ unsigned cvtpk(float lo, float hi) { unsigned r; asm volatile("v_cvt_pk_bf16_f32 %0, %1, %2" : "=v"(r) : "v"(lo), "v"(hi)); return r; }
__device__ __forceinline__ float logsig16(float x) {
    const float e = __builtin_amdgcn_exp2f(-__builtin_fabsf(x) * 1.4426950408889634f);
    const float l = __builtin_amdgcn_logf(1.f + e) * 0.6931471805599453f;
    return (__builtin_fminf(x, 0.f) - l) * 0.0625f;
}
__device__ __forceinline__ float expf_(float x) { return __builtin_amdgcn_exp2f(x * 1.4426950408889634f); }

struct Ptrs {
    bf16_t* GK; const bf16_t* GV; bf16_t* GQ; bf16_t* QEB; bf16_t* KDB; float* GAM; bf16_t* AM; bf16_t* OI; bf16_t* GO; const float* LR;
    const float *w_gk_f, *b_gk_f, *w_gk_b, *b_gk_b, *gla_norm;
};

constexpr int G1_LR = 0, G1_TOT = 8192, G1_QE = 12288, G1_PITCH = 136, G1_KE = G1_QE + 2 * 64 * G1_PITCH * 2;
static_assert(G1_KE + 2 * 64 * G1_PITCH * 2 <= 131072, "G1 LDS");

__device__ __forceinline__ void g1_unit(const Ptrs& p, int bh, int ci, lptr lds, int tid) {
    const int b = bh >> 2, h = bh & 3, d = tid & 127, tq = tid >> 7;
    const size_t pr0 = (size_t)b * P + (size_t)ci * 64;
    const bool isx = ci >= 4; const size_t m0 = (size_t)b * T + (size_t)(ci - 4) * 64;
    __attribute__((address_space(3))) float* LRs = (__attribute__((address_space(3))) float*)(lds + G1_LR);
    __attribute__((address_space(3))) float* TOT = (__attribute__((address_space(3))) float*)(lds + G1_TOT);
    __attribute__((address_space(3))) bf16_t* QEs = (__attribute__((address_space(3))) bf16_t*)(lds + G1_QE);
    __attribute__((address_space(3))) bf16_t* KEs = (__attribute__((address_space(3))) bf16_t*)(lds + G1_KE);
    { const f32x4 v = *(const f32x4*)(p.LR + (pr0 + (tid >> 3)) * 32 + (tid & 7) * 4); *(__attribute__((address_space(3))) f32x4*)(LRs + (tid >> 3) * 32 + (tid & 7) * 4) = v; }
    float kv[16], qv[16];
#pragma unroll
    for (int i = 0; i < 16; ++i) kv[i] = bf2f(p.GK[(pr0 + 16 * tq + i) * 512 + h * 128 + d]);
#pragma unroll
    for (int i = 0; i < 16; ++i) qv[i] = isx ? bf2f(p.GQ[(m0 + 16 * tq + i) * 512 + h * 128 + d]) : 0.f;
    asm volatile("s_waitcnt vmcnt(0)" ::: "memory");
    __syncthreads();
    float cs[2][16];
#pragma unroll
    for (int dir = 0; dir < 2; ++dir) {
        const float* wg = dir ? p.w_gk_b : p.w_gk_f; const float bias = (dir ? p.b_gk_b : p.b_gk_f)[h * 128 + d];
        float w[16];
#pragma unroll
        for (int r = 0; r < 16; ++r) w[r] = wg[r * 512 + h * 128 + d];
        float g[16];
#pragma unroll
        for (int i = 0; i < 16; ++i) { float x = bias;
#pragma unroll
            for (int r = 0; r < 16; ++r) x += LRs[(16 * tq + i) * 32 + dir * 16 + r] * w[r];
            g[i] = logsig16(x); }
        float run = 0.f;
        if (dir == 0) {
#pragma unroll
            for (int i = 0; i < 16; ++i) { run += g[i]; cs[0][i] = run; }
        } else {
#pragma unroll
            for (int i = 15; i >= 0; --i) { run += g[i]; cs[1][i] = run; }
        }
        TOT[(dir * 4 + tq) * 128 + d] = run;
    }
    __syncthreads();
#pragma unroll
    for (int dir = 0; dir < 2; ++dir) {
        const float t0 = TOT[(dir * 4 + 0) * 128 + d], t1 = TOT[(dir * 4 + 1) * 128 + d], t2 = TOT[(dir * 4 + 2) * 128 + d], t3 = TOT[(dir * 4 + 3) * 128 + d];
        const float btot = (t0 + t1) + (t2 + t3);
        float off;
        if (dir == 0) off = (tq > 0 ? t0 : 0.f) + (tq > 1 ? t1 : 0.f) + (tq > 2 ? t2 : 0.f);
        else          off = (tq < 1 ? t1 : 0.f) + (tq < 2 ? t2 : 0.f) + (tq < 3 ? t3 : 0.f);
        unsigned kdw[8];
#pragma unroll
        for (int i = 0; i < 16; i += 2) { const float b0 = off + cs[dir][i], b1 = off + cs[dir][i + 1];
            kdw[i >> 1] = cvtpk(kv[i] * expf_(btot - b0), kv[i + 1] * expf_(btot - b1)); }
        bf16_t* kdp = dir == 0 ? p.GK + (pr0 + (size_t)(d >> 1)) * 512 + h * 128 + (d & 1) * 64 + 16 * tq
                               : p.KDB + (((size_t)bh * NCH + ci) * 128 + d) * 64 + 16 * tq;
        *(u32x4*)kdp = (u32x4){kdw[0], kdw[1], kdw[2], kdw[3]}; *(u32x4*)(kdp + 8) = (u32x4){kdw[4], kdw[5], kdw[6], kdw[7]};
        if (tq == 0) p.GAM[(((size_t)dir * 16 + bh) * NCH + ci) * 128 + d] = expf_(btot);
        if (isx) {
            bf16_t* qdst = (dir == 0 ? p.GQ : p.QEB) + (m0 + 16 * tq) * 512 + h * 128 + d;
#pragma unroll
            for (int i = 0; i < 16; ++i) { const float bi = off + cs[dir][i];
                const bf16_t qe = (bf16_t)f2bf(qv[i] * expf_(bi)), ke = (bf16_t)f2bf(kv[i] * expf_(-bi));
                qdst[(size_t)i * 512] = qe;
                QEs[(dir * 64 + 16 * tq + i) * G1_PITCH + d] = qe; KEs[(dir * 64 + 16 * tq + i) * G1_PITCH + d] = ke; }
        }
    }
    __syncthreads();
    if (isx) {
        const int wave = tid >> 6, lane = tid & 63, fr = lane & 15, fq = lane >> 4, ti = wave >> 1;
        bf16_t* am = p.AM + ((size_t)bh * 64 + (ci - 4)) * 4096;
#pragma unroll
        for (int jj = 0; jj < 2; ++jj) { const int tj = 2 * (wave & 1) + jj;
            f32x4 aF = {0.f, 0.f, 0.f, 0.f}, aB = {0.f, 0.f, 0.f, 0.f};
#pragma unroll
            for (int ks = 0; ks < 4; ++ks) {
                const bf16x8 qf = *(const __attribute__((address_space(3))) bf16x8*)(QEs + (16 * ti + fr) * G1_PITCH + 32 * ks + 8 * fq);
                const bf16x8 kf = *(const __attribute__((address_space(3))) bf16x8*)(KEs + (16 * tj + fr) * G1_PITCH + 32 * ks + 8 * fq);
                const bf16x8 qb = *(const __attribute__((address_space(3))) bf16x8*)(QEs + (64 + 16 * ti + fr) * G1_PITCH + 32 * ks + 8 * fq);
                const bf16x8 kb = *(const __attribute__((address_space(3))) bf16x8*)(KEs + (64 + 16 * tj + fr) * G1_PITCH + 32 * ks + 8 * fq);
                aF = __builtin_amdgcn_mfma_f32_16x16x32_bf16(qf, kf, aF, 0, 0, 0);
                aB = __builtin_amdgcn_mfma_f32_16x16x32_bf16(qb, kb, aB, 0, 0, 0);
            }
#pragma unroll
            for (int r = 0; r < 4; ++r) { const int i = 16 * ti + 4 * fq + r, j = 16 * tj + fr;
                const float v = (j <= i ? aF[r] : 0.f) + (j >= i ? aB[r] : 0.f);
                am[i * 64 + j] = (bf16_t)f2bf(v); }
        }
    }
    __syncthreads();
}

__device__ __forceinline__ void g2_wave(const Ptrs& p, int pair, int dir, lptr vs, volatile __attribute__((address_space(3))) unsigned* prog, int lane) {
    const int bh = pair >> 4, dvb = pair & 15, b = bh >> 2, h = bh & 3, fr = lane & 15, fq = lane >> 4;
    f32x4 S[8];
#pragma unroll
    for (int td = 0; td < 8; ++td) S[td] = (f32x4){0.f, 0.f, 0.f, 0.f};
    const bf16_t* QE = dir == 0 ? p.GQ : p.QEB;
    for (int s = 0; s < NCH; ++s) {
        const int ci = dir == 0 ? s : (s < 4 ? 3 - s : 71 - s);
        const size_t pr0 = (size_t)b * P + (size_t)ci * 64;
        const bool isx = ci >= 4; const int c = ci - 4; const size_t m0 = (size_t)b * T + (size_t)c * 64;
        const bf16_t* vp = p.GV + (pr0 + lane) * 1024 + h * 256 + 16 * dvb;
        const u32x4 v0 = *(const u32x4*)vp, v1 = *(const u32x4*)(vp + 8);
        if (isx) {
            bf16x8 Sb[4];
#pragma unroll
            for (int u = 0; u < 4; ++u) { const u32x4 w = {cvtpk(S[2 * u][0], S[2 * u][1]), cvtpk(S[2 * u][2], S[2 * u][3]), cvtpk(S[2 * u + 1][0], S[2 * u + 1][1]), cvtpk(S[2 * u + 1][2], S[2 * u + 1][3])};
                Sb[u] = __builtin_bit_cast(bf16x8, w); }
            const bool second = dir == 0 ? (c >= 32) : (c <= 31);
            if (second) { const unsigned need = dir == 0 ? (unsigned)(68 - c) : (unsigned)(c + 5); unsigned sp = 0;
                while (prog[1 - dir] < need) { __builtin_amdgcn_s_sleep(2); if (++sp > (1u << 22)) break; } }
            const bf16_t* qp = QE + (m0 + fr) * 512 + h * 128 + 4 * fq;
            bf16_t* op = p.OI + (m0 + 4 * fq) * 1024 + h * 256 + 16 * dvb + fr;
#pragma unroll
            for (int tt = 0; tt < 4; ++tt) {
                f32x4 acc = {0.f, 0.f, 0.f, 0.f};
#pragma unroll
                for (int u = 0; u < 4; ++u) {
                    const u32x2 lo = *(const u32x2*)(qp + (size_t)(16 * tt) * 512 + 32 * u), hi = *(const u32x2*)(qp + (size_t)(16 * tt) * 512 + 32 * u + 16);
                    const u32x4 aw = {lo.x, lo.y, hi.x, hi.y};
                    acc = __builtin_amdgcn_mfma_f32_16x16x32_bf16(__builtin_bit_cast(bf16x8, aw), Sb[u], acc, 0, 0, 0);
                }
#pragma unroll
                for (int r = 0; r < 4; ++r) { bf16_t* o1 = op + (size_t)(16 * tt + r) * 1024; float v = acc[r]; if (second) v += bf2f(*o1); *o1 = (bf16_t)f2bf(v); }
            }
        }
        { __attribute__((address_space(3))) u32x2* w = (__attribute__((address_space(3))) u32x2*)(vs + lane * 40);
          w[0] = (u32x2){v0.x, v0.y}; w[1] = (u32x2){v0.z, v0.w}; w[2] = (u32x2){v1.x, v1.y}; w[3] = (u32x2){v1.z, v1.w}; }
        bf16x8 vB[2];
#pragma unroll
        for (int ks = 0; ks < 2; ++ks) {
            const lds_cptr a0 = (lds_cptr)vs + (32 * ks + 8 * fq + (fr >> 2)) * 40 + (fr & 3) * 8;
            const s16x4 l = vtr(a0), hh = vtr(a0 + 4 * 40);
            vB[ks] = (bf16x8){l[0], l[1], l[2], l[3], hh[0], hh[1], hh[2], hh[3]};
        }
        const float* gp = p.GAM + (((size_t)dir * 16 + bh) * NCH + ci) * 128 + 4 * fq;
#pragma unroll
        for (int td = 0; td < 8; ++td) {
            const int d = 16 * td + fr;
            const bf16_t* kp = dir == 0 ? p.GK + (pr0 + (size_t)(d >> 1)) * 512 + h * 128 + (d & 1) * 64 + 8 * fq
                                        : p.KDB + (((size_t)bh * NCH + ci) * 128 + d) * 64 + 8 * fq;
            const bf16x8 a0 = *(const bf16x8*)kp, a1 = *(const bf16x8*)(kp + 32);
            const f32x4 gm = *(const f32x4*)(gp + 16 * td);
            f32x4 sv = S[td] * gm;
            sv = __builtin_amdgcn_mfma_f32_16x16x32_bf16(a0, vB[0], sv, 0, 0, 0);
            sv = __builtin_amdgcn_mfma_f32_16x16x32_bf16(a1, vB[1], sv, 0, 0, 0);
            S[td] = sv;
        }
        asm volatile("s_waitcnt vmcnt(0)" ::: "memory");
        if (lane == 0) prog[dir] = (unsigned)(s + 1);
    }
}

constexpr int G3_SS = 32768;
__device__ __forceinline__ void g3_unit(const Ptrs& p, int bh, int c, lptr lds, int tid) {
    const int b = bh >> 2, h = bh & 3, wave = tid >> 6, lane = tid & 63, r32 = lane & 31, hi = lane >> 5;
    const size_t pr0 = (size_t)b * P + (size_t)(c + 4) * 64, m0 = (size_t)b * T + (size_t)c * 64;
    { const int sr = tid >> 4, sc = (tid & 15) * 8;
#pragma unroll
      for (int tile = 0; tile < 2; ++tile)
#pragma unroll
          for (int rr = 0; rr < 2; ++rr) { const int row = sr + 32 * rr;
              const bf16x8 x = *(const bf16x8*)(p.GV + (pr0 + row) * 1024 + h * 256 + tile * 128 + sc);
              *(__attribute__((address_space(3))) bf16x8*)(lds + tile * 16384 + att::v_st(row, sc)) = x; } }
    const int tt = wave & 1, dq = wave >> 1, t = 32 * tt + r32;
    const bf16_t* ap = p.AM + (((size_t)bh * 64 + c) * 64 + t) * 64 + 8 * hi;
    bf16x8 bfr[4];
#pragma unroll
    for (int ks = 0; ks < 4; ++ks) bfr[ks] = *(const bf16x8*)(ap + 16 * ks);
    __syncthreads();
    f32x16 od[2];
#pragma unroll
    for (int k2 = 0; k2 < 2; ++k2) {
#pragma unroll
        for (int r = 0; r < 16; ++r) od[k2][r] = 0.f;
        const int dvt = 2 * dq + k2, tile = dvt >> 2, d0 = dvt & 3;
        const lds_cptr vb = (lds_cptr)lds + tile * 16384 + att::v_rd_base(lane) + d0 * 512;
#pragma unroll
        for (int ks = 0; ks < 4; ++ks) {
            const s16x4 l = vtr(vb + ks * 4096), hh = vtr(vb + ks * 4096 + 2048);
            const bf16x8 va = (bf16x8){l[0], l[1], l[2], l[3], hh[0], hh[1], hh[2], hh[3]};
            od[k2] = __builtin_amdgcn_mfma_f32_32x32x16_bf16(va, bfr[ks], od[k2], 0, 0, 0);
        }
    }
    const size_t rowp = (m0 + t) * 1024 + h * 256;
    float ss = 0.f;
#pragma unroll
    for (int k2 = 0; k2 < 2; ++k2)
#pragma unroll
        for (int g4 = 0; g4 < 4; ++g4) { const int dv0 = 64 * dq + 32 * k2 + 8 * g4 + 4 * hi;
            const u32x2 w = *(const u32x2*)(p.OI + rowp + dv0);
            od[k2][4 * g4 + 0] += bflo(w.x); od[k2][4 * g4 + 1] += bfhi(w.x); od[k2][4 * g4 + 2] += bflo(w.y); od[k2][4 * g4 + 3] += bfhi(w.y);
#pragma unroll
            for (int e = 0; e < 4; ++e) ss += od[k2][4 * g4 + e] * od[k2][4 * g4 + e]; }
    ss += __shfl_xor(ss, 32);
    __attribute__((address_space(3))) float* SS = (__attribute__((address_space(3))) float*)(lds + G3_SS);
    if (hi == 0) SS[t * 4 + dq] = ss;
    __syncthreads();
    const float tot = (SS[t * 4 + 0] + SS[t * 4 + 1]) + (SS[t * 4 + 2] + SS[t * 4 + 3]);
    const float rstd = __builtin_amdgcn_rsqf(tot * (1.f / 256.f) + EPS);
#pragma unroll
    for (int k2 = 0; k2 < 2; ++k2)
#pragma unroll
        for (int g4 = 0; g4 < 4; ++g4) { const int dv0 = 64 * dq + 32 * k2 + 8 * g4 + 4 * hi;
            const u32x2 gw = *(const u32x2*)(p.GO + rowp + dv0); const f32x4 gn = *(const f32x4*)(p.gla_norm + dv0);
            const float g0 = bflo(gw.x), g1 = bfhi(gw.x), g2 = bflo(gw.y), g3 = bfhi(gw.y);
            const float y0 = od[k2][4 * g4 + 0] * rstd * gn[0] * (g0 * sigmoidf_(g0)), y1 = od[k2][4 * g4 + 1] * rstd * gn[1] * (g1 * sigmoidf_(g1));
            const float y2 = od[k2][4 * g4 + 2] * rstd * gn[2] * (g2 * sigmoidf_(g2)), y3 = od[k2][4 * g4 + 3] * rstd * gn[3] * (g3 * sigmoidf_(g3));
            *(u32x2*)(p.GO + rowp + dv0) = (u32x2){cvtpk(y0, y1), cvtpk(y2, y3)}; }
    __syncthreads();
}
}

namespace pro {
typedef __attribute__((address_space(3))) unsigned char* lptr;
typedef __attribute__((address_space(3))) float* lfp;
__device__ __forceinline__ unsigned pk2f(float lo, float hi) { return f2bf(lo) | (f2bf(hi) << 16); }

__device__ __forceinline__ void ada_item(int jb, const float* __restrict__ c, const float* __restrict__ c_ctx, const float* __restrict__ w_ada, const float* __restrict__ b_ada,
                                         float* __restrict__ MODX, float* __restrict__ MODC, lptr lds, int tid) {
    lfp SC = (lfp)lds; lfp RED = (lfp)(lds + 20480);
    for (int e = tid; e < 5120; e += 512) { const int r = e >> 10, k = e & 1023; const float x = r < 4 ? c[r * 1024 + k] : c_ctx[k]; SC[e] = x / (1.f + __expf(-x)); }
    __syncthreads();
    const int c4 = tid & 7, kk = tid >> 3;
    f32x4 acc[5];
#pragma unroll
    for (int r = 0; r < 5; ++r) acc[r] = (f32x4){0.f, 0.f, 0.f, 0.f};
#pragma unroll 4
    for (int i = 0; i < 16; ++i) { const int k = kk + 64 * i; const f32x4 w = *(const f32x4*)(w_ada + (size_t)k * 6144 + jb * 32 + c4 * 4);
#pragma unroll
        for (int r = 0; r < 5; ++r) acc[r] += w * SC[r * 1024 + k]; }
#pragma unroll
    for (int r = 0; r < 5; ++r) *(__attribute__((address_space(3))) f32x4*)(RED + (kk * 5 + r) * 32 + c4 * 4) = acc[r];
    __syncthreads();
    if (tid < 160) { const int r = tid >> 5, jl = tid & 31, j = jb * 32 + jl; float s = 0.f;
        for (int q = 0; q < 64; ++q) s += RED[(q * 5 + r) * 32 + jl];
        s += b_ada[j];
        if (r < 4) MODX[r * 6144 + j] = s; else if (j < 2048) MODC[j] = s; }
    __syncthreads();
}
__device__ __forceinline__ void conv_item(const float* __restrict__ W, int K, int N, int src_n0, bf16_t* __restrict__ WT, int dst_n0, int k0, lfp scr, int lane) {
#pragma unroll 8
    for (int i = 0; i < 32; ++i) { const int kk = 2 * i + (lane >> 5); scr[kk * 33 + (lane & 31)] = src_n0 >= 0 ? W[(size_t)(k0 + kk) * N + src_n0 + (lane & 31)] : 0.f; }
    asm volatile("s_waitcnt lgkmcnt(0)" ::: "memory");
    const int c = lane & 7;
#pragma unroll
    for (int j = 0; j < 4; ++j) { const int n = (lane >> 3) + 8 * j; const lfp s = scr + (8 * c) * 33 + n;
        u32x4 o; o.x = pk2f(s[0 * 33], s[1 * 33]); o.y = pk2f(s[2 * 33], s[3 * 33]); o.z = pk2f(s[4 * 33], s[5 * 33]); o.w = pk2f(s[6 * 33], s[7 * 33]);
        *(u32x4*)(WT + (size_t)(dst_n0 + n) * K + k0 + 8 * c) = o; }
    asm volatile("s_waitcnt lgkmcnt(0)" ::: "memory");
}
struct Weights { const float *w_in, *wa, *wg, *wo, *w1, *w2; bf16_t *WinT, *WaT, *WgT, *WoT, *W1T, *W2T; };
constexpr int I_IN = 16 * 210, I_SQ = 16 * 32, I_W1 = 16 * 128, I_W2 = 64 * 32, I_ALL = I_IN + 3 * I_SQ + I_W1 + I_W2;
__device__ __forceinline__ void conv_any(const Weights& w, int it, lfp scr, int lane) {
    if (it < I_IN) { const int kb = it / 210, nb = it % 210; conv_item(w.w_in, 1024, 6688, win_src_col(32 * nb), w.WinT, 32 * nb, 64 * kb, scr, lane); return; } it -= I_IN;
    if (it < I_SQ) { conv_item(w.wa, 1024, 1024, 32 * (it & 31), w.WaT, 32 * (it & 31), 64 * (it >> 5), scr, lane); return; } it -= I_SQ;
    if (it < I_SQ) { conv_item(w.wg, 1024, 1024, 32 * (it & 31), w.WgT, 32 * (it & 31), 64 * (it >> 5), scr, lane); return; } it -= I_SQ;
    if (it < I_SQ) { conv_item(w.wo, 1024, 1024, 32 * (it & 31), w.WoT, 32 * (it & 31), 64 * (it >> 5), scr, lane); return; } it -= I_SQ;
    if (it < I_W1) { conv_item(w.w1, 1024, 4096, 32 * (it & 127), w.W1T, 32 * (it & 127), 64 * (it >> 7), scr, lane); return; } it -= I_W1;
    conv_item(w.w2, 4096, 1024, 32 * (it & 31), w.W2T, 32 * (it & 31), 64 * (it >> 5), scr, lane);
}
__device__ __forceinline__ void norm_mod_row(const float* __restrict__ xr, const float* __restrict__ gw, const float* __restrict__ sh, const float* __restrict__ sc, bf16_t* __restrict__ orow, int lane) {
    f32x4 v[4]; float s = 0.f;
#pragma unroll
    for (int j = 0; j < 4; ++j) { v[j] = *(const f32x4*)(xr + 4 * lane + 256 * j); s += (v[j][0] * v[j][0] + v[j][1] * v[j][1]) + (v[j][2] * v[j][2] + v[j][3] * v[j][3]); }
    const float r = __builtin_amdgcn_rsqf(wave_sum(s) * (1.f / 1024.f) + EPS);
#pragma unroll
    for (int j = 0; j < 4; ++j) { const int k = 4 * lane + 256 * j; const f32x4 g = *(const f32x4*)(gw + k), a = *(const f32x4*)(sc + k), b = *(const f32x4*)(sh + k);
        const f32x4 y = (v[j] * r * g) * (a + 1.f) + b;
        *(u32x2*)(orow + k) = (u32x2){pk2f(y[0], y[1]), pk2f(y[2], y[3])}; }
}
__device__ __forceinline__ void qkrope_chunk(bf16_t* __restrict__ chunk, const float* __restrict__ gw, const float* __restrict__ rope, int pos, bool dorope, int lane) {
    const int sub = lane & 7;
    bf16_t* p = chunk + (lane >> 3) * 128 + sub * 16;
    const u32x4 w0 = *(const u32x4*)p, w1 = *(const u32x4*)(p + 8);
    float v[16];
    v[0] = bflo(w0.x); v[1] = bfhi(w0.x); v[2] = bflo(w0.y); v[3] = bfhi(w0.y); v[4] = bflo(w0.z); v[5] = bfhi(w0.z); v[6] = bflo(w0.w); v[7] = bfhi(w0.w);
    v[8] = bflo(w1.x); v[9] = bfhi(w1.x); v[10] = bflo(w1.y); v[11] = bfhi(w1.y); v[12] = bflo(w1.z); v[13] = bfhi(w1.z); v[14] = bflo(w1.w); v[15] = bfhi(w1.w);
    float s = 0.f;
#pragma unroll
    for (int i = 0; i < 16; ++i) s += v[i] * v[i];
    s += __shfl_xor(s, 1); s += __shfl_xor(s, 2); s += __shfl_xor(s, 4);
    const float r = __builtin_amdgcn_rsqf(s * (1.f / 128.f) + EPS);
#pragma unroll
    for (int i = 0; i < 16; i += 4) { const f32x4 g = *(const f32x4*)(gw + sub * 16 + i); v[i] *= r * g[0]; v[i + 1] *= r * g[1]; v[i + 2] *= r * g[2]; v[i + 3] *= r * g[3]; }
    if (dorope) {
        const int axis = sub >> 2, half = (sub >> 1) & 1, f0 = (sub & 1) * 16;
        const int ap = axis == 0 ? (pos >> 6) : (pos & 63);
        const float* rp = rope + (size_t)(ap * 32 + f0) * 2;
#pragma unroll
        for (int i = 0; i < 16; i += 2) { const f32x4 cs = *(const f32x4*)(rp + 2 * i);
            const float q0 = __shfl_xor(v[i], 2), q1 = __shfl_xor(v[i + 1], 2);
            v[i] = half == 0 ? v[i] * cs[0] - q0 * cs[1] : v[i] * cs[0] + q0 * cs[1];
            v[i + 1] = half == 0 ? v[i + 1] * cs[2] - q1 * cs[3] : v[i + 1] * cs[2] + q1 * cs[3]; }
    }
    *(u32x4*)p = (u32x4){pk2f(v[0], v[1]), pk2f(v[2], v[3]), pk2f(v[4], v[5]), pk2f(v[6], v[7])};
    *(u32x4*)(p + 8) = (u32x4){pk2f(v[8], v[9]), pk2f(v[10], v[11]), pk2f(v[12], v[13]), pk2f(v[14], v[15])};
}
}


constexpr int RING_OFF = 0, RING_BYTES = 131072;
constexpr int LDSCTL_OFF = RING_BYTES, MISC_OFF = LDSCTL_OFF + 320;
constexpr int LDS_BYTES = 147456;
constexpr int NWAVES = 8;
constexpr int CW_BAR = 4096;

enum Phase { PH_PRO = 0, PH_NORM1, PH_INPROJ, PH_QKROPE, PH_ATTN, PH_G1, PH_G2, PH_G3, PH_MERGE, PH_OUT, PH_NORM2, PH_MLP1, PH_MLP2, PH_END };

struct Args { const float* in[21]; float* out; unsigned char* ws; int ph_lo, ph_hi; };

__device__ __forceinline__ void lr_unit(const bf16_t* __restrict__ XNall, const bf16_t* __restrict__ WlrT, float* __restrict__ LR, int u, int wave, int lane) {
    const int r32 = lane & 31, hi = lane >> 5;
    const bf16_t* ap = XNall + (size_t)(u * 256 + wave * 32 + r32) * 1024 + hi * 8;
    const bf16_t* bp = WlrT + (size_t)r32 * 1024 + hi * 8;
    f32x16 acc;
#pragma unroll
    for (int r = 0; r < 16; ++r) acc[r] = 0.f;
#pragma unroll 8
    for (int k0 = 0; k0 < 1024; k0 += 16) {
        const bf16x8 a = *(const bf16x8*)(ap + k0), b = *(const bf16x8*)(bp + k0);
        acc = __builtin_amdgcn_mfma_f32_32x32x16_bf16(a, b, acc, 0, 0, 0);
    }
#pragma unroll
    for (int r = 0; r < 16; ++r) { const int m = u * 256 + wave * 32 + crow(r, hi); LR[prow(m) * 32 + r32] = acc[r]; }
}

__global__ void __launch_bounds__(NWAVES * 64, 2) mk_fwd(Args args) {
    extern __shared__ __attribute__((aligned(16))) unsigned char lds[];
    LAS unsigned char* ldsl = (LAS unsigned char*)lds;
    volatile LAS unsigned* MISC = (volatile LAS unsigned*)(ldsl + MISC_OFF);
    const int tid = threadIdx.x, lane = tid & 63, wave = __builtin_amdgcn_readfirstlane(tid >> 6);
    const int G = gridDim.x, bx = blockIdx.x;
    unsigned char* ws = args.ws;
    gu32* ctl = (gu32*)(ws + WS_CTL);
    float* out = args.out;
    float* MODX = (float*)(ws + WS_MODX);
    bf16_t* WinT = (bf16_t*)(ws + WS_WIN); bf16_t* WaT = (bf16_t*)(ws + WS_WA); bf16_t* WgT = (bf16_t*)(ws + WS_WG); bf16_t* WoT = (bf16_t*)(ws + WS_WO);
    bf16_t* W1T = (bf16_t*)(ws + WS_W1); bf16_t* W2T = (bf16_t*)(ws + WS_W2);
    bf16_t* KA = (bf16_t*)(ws + WS_KA); bf16_t* VA = (bf16_t*)(ws + WS_VA); bf16_t* GK = (bf16_t*)(ws + WS_GK); bf16_t* GV = (bf16_t*)(ws + WS_GV); float* LR = (float*)(ws + WS_LR);
    bf16_t* QA = (bf16_t*)(ws + WS_QA); bf16_t* GQ = (bf16_t*)(ws + WS_GQ); bf16_t* GO = (bf16_t*)(ws + WS_GO); bf16_t* GA = (bf16_t*)(ws + WS_GA); bf16_t* GG = (bf16_t*)(ws + WS_GG);
    bf16_t* Y = (bf16_t*)(ws + WS_Y); bf16_t* HN = (bf16_t*)(ws + WS_HN); bf16_t* H = (bf16_t*)(ws + WS_H);
    bf16_t* XN = (bf16_t*)args.out;

    for (int u = tid; u < (LDS_BYTES - LDSCTL_OFF) / 4; u += NWAVES * 64) ((LAS unsigned*)(ldsl + LDSCTL_OFF))[u] = 0u;
    __syncthreads();
    const int lo = args.ph_lo, hi = args.ph_hi;
    const bool multi = (hi - lo) > 1;
    XcdBarrier bar; bar.bar = (unsigned*)(ctl + CW_BAR); bar.x = 0; bar.st = nullptr;
    if (multi) bar = xcd_barrier_post((unsigned*)(ctl + CW_BAR), MISC + 8);
#define IN(k) (lo <= (k) && (k) < hi)
#define SEAM(k) do { if (IN(k) && IN((k) + 1)) xcd_barrier(bar); } while (0)

    if (IN(PH_PRO)) {
        for (int jb = bx; jb < 192; jb += G) pro::ada_item(jb, args.in[1], args.in[3], args.in[4], args.in[5], MODX, (float*)(ws + WS_MODC), ldsl + RING_OFF, tid);
        if (bx == G - 1) { float* rope = (float*)(ws + WS_ROPE);
            for (int i = tid; i < 64 * 32; i += NWAVES * 64) { const int pos = i >> 5, f = i & 31; const float ang = (float)pos * powf(10000.f, -(float)(2 * f) / 64.f); rope[2 * i] = cosf(ang); rope[2 * i + 1] = sinf(ang); } }
        const pro::Weights W{args.in[7], args.in[15], args.in[16], args.in[17], args.in[19], args.in[20], WinT, WaT, WgT, WoT, W1T, W2T};
        for (int it = bx * NWAVES + wave; it < pro::I_ALL; it += G * NWAVES) pro::conv_any(W, it, (pro::lfp)(ldsl + RING_OFF + wave * 16384), lane);
    }
    SEAM(PH_PRO);
    if (IN(PH_NORM1)) {
        const float* MODC = (const float*)(ws + WS_MODC);
        for (int row = bx * NWAVES + wave; row < MALL; row += G * NWAVES) {
            if (row < M) { const float* sh = MODX + (size_t)(row >> 12) * 6144; pro::norm_mod_row(args.in[0] + (size_t)row * DM, args.in[6], sh, sh + DM, XN + (size_t)row * DM, lane); }
            else pro::norm_mod_row(args.in[2] + (size_t)(row - M) * DM, args.in[6], MODC, MODC + DM, XN + (size_t)row * DM, lane);
        }
    }
    SEAM(PH_NORM1);
    if (IN(PH_INPROJ)) {
        pg8::Gemm g{XN, WinT, MALL, NIN, DM}; pg8::InOrder S; S.init(G, bx);
        pg8::EpiInProj E{KA, VA, GK, GV, QA, GQ, GO, GA, GG};
        pg8::gemm_phase<pg8::EpiInProj, pg8::InOrder, true, true>(ldsl + RING_OFF, g, S, E);
        if (bx >= 160 && bx < 160 + 68) lr_unit(XN, WinT + (size_t)NIN * DM, LR, bx - 160, wave, lane);
    }
    SEAM(PH_INPROJ);
    if (IN(PH_QKROPE)) {
        const float* rope = (const float*)(ws + WS_ROPE);
        for (int ch = bx * NWAVES + wave; ch < M + NB * P / 4; ch += G * NWAVES) {
            if (ch < M) pro::qkrope_chunk(QA + (size_t)ch * 1024, args.in[8], rope, ch & 4095, true, lane);
            else { const int ki = ch - M, row = 4 * ki + (lane >> 4), pp = row % P;
                   pro::qkrope_chunk(KA + (size_t)ki * 1024, args.in[9], rope, pp - CTX, ((4 * ki) % P) >= CTX, lane); }
        }
    }
    SEAM(PH_QKROPE);
    if (IN(PH_ATTN)) {
        for (int L = bx; L < 512; L += G) { const int xg = L & 7, u = L >> 3, b = xg >> 1, kvh = xg & 1, h = kvh * 4 + (u >> 4), qb = u & 15;
            bf16_t* Qb = QA + ((size_t)(b * T + qb * 256)) * 1024 + h * 128;
            att::attn_dense_body<att::bf16>(Qb, KA + (size_t)b * P * 256 + kvh * 128, VA + (size_t)b * P * 256 + kvh * 128, Qb, P, (char*)lds + RING_OFF); }
    }
    SEAM(PH_ATTN);
    gla::Ptrs gp{GK, GV, GQ, (bf16_t*)(ws + WS_QEB), (bf16_t*)((unsigned char*)args.out + DO_KDB), (float*)(ws + WS_GAM), (bf16_t*)((unsigned char*)args.out + DO_AM), (bf16_t*)((unsigned char*)args.out + DO_OI), GO, LR,
                 args.in[10], args.in[11], args.in[12], args.in[13], args.in[14]};
    if (IN(PH_G1)) { for (int L = bx; L < 16 * NCH; L += G) gla::g1_unit(gp, L & 15, L >> 4, ldsl + RING_OFF, tid); }
    SEAM(PH_G1);
    if (IN(PH_G2)) {
        volatile LAS unsigned* prog = (volatile LAS unsigned*)(ldsl + RING_OFF + 65536);
        for (int L = bx; L < 256; L += G) {
            if (tid == 0) { prog[0] = 0u; prog[1] = 0u; }
            __syncthreads();
            if (wave < 2) gla::g2_wave(gp, L, wave, ldsl + RING_OFF + wave * 4096, prog, lane);
            __syncthreads();
        }
    }
    SEAM(PH_G2);
    if (IN(PH_G3)) { for (int L = bx; L < 1024; L += G) gla::g3_unit(gp, L & 15, L >> 4, ldsl + RING_OFF, tid); }
    SEAM(PH_G3);
    if (IN(PH_MERGE)) {
        { pg8::Gemm g{QA, WaT, M, DM, DM}; pg8::StaticOrder S; S.init(M, DM, G, bx); pg8::EpiMerge<true> E{GA, Y};
          pg8::gemm_phase<pg8::EpiMerge<true>, pg8::StaticOrder, false, true>(ldsl + RING_OFF, g, S, E); }
        { pg8::Gemm g{GO, WgT, M, DM, DM}; pg8::StaticOrder S; S.init(M, DM, G, bx); pg8::EpiMerge<false> E{GG, Y};
          pg8::gemm_phase<pg8::EpiMerge<false>, pg8::StaticOrder, false, true>(ldsl + RING_OFF, g, S, E); }
    }
    SEAM(PH_MERGE);
    if (IN(PH_OUT)) {
        pg8::Gemm g{Y, WoT, M, DM, DM}; pg8::StaticOrder S; S.init(M, DM, G, bx); pg8::EpiGateRes E{args.in[0], out, MODX + 2 * DM};
        pg8::gemm_phase<pg8::EpiGateRes, pg8::StaticOrder, false, true>(ldsl + RING_OFF, g, S, E);
    }
    SEAM(PH_OUT);
    if (IN(PH_NORM2)) {
        for (int row = bx * NWAVES + wave; row < M; row += G * NWAVES) { const float* sh = MODX + (size_t)(row >> 12) * 6144 + 3 * DM;
            pro::norm_mod_row(out + (size_t)row * DM, args.in[18], sh, sh + DM, HN + (size_t)row * DM, lane); }
    }
    SEAM(PH_NORM2);
    if (IN(PH_MLP1)) {
        pg8::Gemm g{HN, W1T, M, FF, DM}; pg8::StaticOrder S; S.init(M, FF, G, bx); pg8::EpiSqRelu E{H};
        pg8::gemm_phase<pg8::EpiSqRelu, pg8::StaticOrder, true, true>(ldsl + RING_OFF, g, S, E);
    }
    SEAM(PH_MLP1);
    if (IN(PH_MLP2)) {
        pg8::Gemm g{H, W2T, M, DM, FF}; pg8::StaticOrder S; S.init(M, DM, G, bx); pg8::EpiGateRes E{out, out, MODX + 5 * DM};
        pg8::gemm_phase<pg8::EpiGateRes, pg8::StaticOrder, false, true>(ldsl + RING_OFF, g, S, E);
    }
#undef IN
#undef SEAM
}

extern "C" void kernel_launch(void* const* d_in, const int* in_sizes, int n_in, void* d_out, int out_size, void* d_ws, size_t ws_size, hipStream_t stream) {
    (void)in_sizes; (void)n_in; (void)out_size; (void)ws_size;
    static int grid = 0;
    if (grid == 0) {
        int dev = 0, cus = 0, per_cu = 0;
        if (hipGetDevice(&dev) != hipSuccess || hipDeviceGetAttribute(&cus, hipDeviceAttributeMultiprocessorCount, dev) != hipSuccess) { fprintf(stderr, "kernel_launch: device query failed\n"); grid = -1; return; }
        if (hipFuncSetAttribute((const void*)mk_fwd, hipFuncAttributeMaxDynamicSharedMemorySize, LDS_BYTES) != hipSuccess) { fprintf(stderr, "kernel_launch: hipFuncSetAttribute failed\n"); grid = -1; return; }
        if (hipOccupancyMaxActiveBlocksPerMultiprocessor(&per_cu, (const void*)mk_fwd, NWAVES * 64, LDS_BYTES) != hipSuccess || per_cu < 1) { fprintf(stderr, "kernel_launch: occupancy query says %d blocks/CU\n", per_cu); per_cu = 1; }
        (void)hipGetLastError();
        grid = cus;
        if (grid != 256) fprintf(stderr, "kernel_launch: %d CUs (built for 256)\n", grid);
    }
    if (grid < 0) return;
    unsigned char* ws = (unsigned char*)d_ws; float* out = (float*)d_out;
    (void)hipMemsetAsync(ws + WS_CTL, 0, CTL_ZERO_BYTES, stream);
    Args a{}; for (int i = 0; i < 21; ++i) a.in[i] = (const float*)d_in[i]; a.out = out; a.ws = ws;
#ifndef MK_PER_PHASE
    a.ph_lo = 0; a.ph_hi = PH_END; hipLaunchKernelGGL(mk_fwd, dim3(grid), dim3(NWAVES * 64), LDS_BYTES, stream, a);
#else
    for (int p = 0; p < PH_END; ++p) { a.ph_lo = p; a.ph_hi = p + 1; hipLaunchKernelGGL(mk_fwd, dim3(grid), dim3(NWAVES * 64), LDS_BYTES, stream, a); }
#endif
    const hipError_t le = hipPeekAtLastError();
    if (le != hipSuccess) fprintf(stderr, "kernel_launch: launch failed: %s\n", hipGetErrorName(le));
}
```

```cpp
#include <hip/hip_runtime.h>
#include <cstdio>
#include <cstdint>

constexpr int NB = 4, T = 4096, DM = 1024, CTX = 256, P = CTX + T  ;
constexpr int M = NB * T, MC = NB * CTX, MALL = M + MC;
constexpr int NIN = 6656;
constexpr int FF = 4096;
constexpr int NCH = P / 64;
constexpr float EPS = 1e-6f;
constexpr float QSCALE = 0.08838834764831845f;

constexpr size_t MiB = 1u << 20;
constexpr size_t WS_CTL = 0, CTL_ZERO_BYTES = 1 * MiB;
constexpr size_t WS_MODX = 1 * MiB, WS_MODC = 1 * MiB + 128 * 1024, WS_ROPE = 1 * MiB + 192 * 1024;
constexpr size_t WS_GAM = 2 * MiB;
constexpr size_t WS_WIN = 4 * MiB, WS_WA = 18 * MiB, WS_WG = 20 * MiB, WS_WO = 22 * MiB, WS_W1 = 24 * MiB, WS_W2 = 32 * MiB;
constexpr size_t WS_QEB = 40 * MiB;
constexpr size_t WS_KA = 40 * MiB, WS_VA = WS_KA + (size_t)NB * P * 256 * 2, WS_GK = 57 * MiB, WS_GV = 74 * MiB, WS_LR = 108 * MiB;
constexpr size_t WS_QA = 111 * MiB, WS_GQ = 143 * MiB, WS_GO = 159 * MiB, WS_GA = 191 * MiB, WS_GG = 223 * MiB;
constexpr size_t WS_Y = WS_GA;
constexpr size_t WS_OIB = WS_QA;
constexpr size_t WS_HN = 191 * MiB, WS_H = 40 * MiB;
static_assert(WS_VA + (size_t)NB * P * 256 * 2 <= WS_GK, "map");
constexpr size_t DO_OI = 0, DO_KDB = 32 * MiB, DO_AM = 49 * MiB;

typedef unsigned short bf16_t;
typedef short bf16x8 __attribute__((ext_vector_type(8)));
typedef float f32x4 __attribute__((ext_vector_type(4)));
typedef float f32x16 __attribute__((ext_vector_type(16)));
typedef unsigned u32x4 __attribute__((ext_vector_type(4)));
typedef unsigned u32x2 __attribute__((ext_vector_type(2)));

__device__ __forceinline__ unsigned f2bf(float f) { unsigned u = __builtin_bit_cast(unsigned, f); return (u + 0x7fffu + ((u >> 16) & 1u)) >> 16; }
__device__ __forceinline__ float bf2f(bf16_t h) { return __builtin_bit_cast(float, (unsigned)h << 16); }
__device__ __forceinline__ float bflo(unsigned w) { return __builtin_bit_cast(float, w << 16); }
__device__ __forceinline__ float bfhi(unsigned w) { return __builtin_bit_cast(float, w & 0xffff0000u); }
__device__ __forceinline__ float wave_sum(float v) {
#pragma unroll
    for (int o = 1; o < 64; o <<= 1) v += __shfl_xor(v, o);
    return v;
}
__device__ __forceinline__ float sigmoidf_(float x) { return __builtin_amdgcn_rcpf(1.f + __builtin_amdgcn_exp2f(-1.4426950408889634f * x)); }
__device__ __forceinline__ size_t prow(int m) {
    if (m < M) { const int b = m >> 12, t = m & 4095; return (size_t)b * P + CTX + t; }
    const int mc = m - M; const int b = mc >> 8, s = mc & 255; return (size_t)b * P + s;
}
__device__ __forceinline__ int crow(int r, int hi) { return (r & 3) + 8 * (r >> 2) + 4 * hi; }
__device__ __forceinline__ int win_src_col(int nd) {
    if (nd < 2048) return nd;
    if (nd < 6656) return nd + 32;
    if (nd < 6688) return 2048 + (nd - 6656);
    return -1;
}
namespace pg8 {
#define PG8_LAS __attribute__((address_space(3)))
typedef unsigned short bf16_t;
typedef short bf16x8 __attribute__((ext_vector_type(8)));
typedef float f32x4 __attribute__((ext_vector_type(4)));
typedef unsigned u32x4 __attribute__((ext_vector_type(4)));
constexpr int BM = 256, BK = 64, HALF = 128, HTB = HALF * BK * 2  , STAGE_BYTES = 8 * HTB, NXCD = 8, WGM = 8;

__host__ __device__ __forceinline__ int lds_byte(int r, int c) { const int st = (r >> 4) * 2 + (c >> 5), rr = r & 15, cc = c & 31, ob = rr * 64 + cc * 2; return st * 1024 + (ob ^ (((ob >> 9) & 1) << 5)); }
__host__ __device__ __forceinline__ void stage_rc(int b, int& R, int& C) { const int st = b / 1024, sb = b % 1024, swz = sb ^ (((sb >> 9) & 1) << 5); R = (st >> 1) * 16 + swz / 64; C = (st & 1) * 32 + (swz % 64) / 2; }
__host__ __device__ __forceinline__ int perm32(int rho) { const int n = rho >> 4, i = rho & 15; return 8 * (i >> 2) + 4 * n + (i & 3); }

struct Unit { int pm, pn; };
struct Gemm { const bf16_t* A; const bf16_t* Bt; int M, N, K; };

struct StaticOrder {
    int nM, nN, nwg, G, c;
    __host__ __device__ void init(int M, int N, int G_, int c_) { nM = M / BM; nN = N / BM; nwg = nM * nN; G = G_; c = c_; }
    __host__ __device__ bool next(int i, Unit& u) const {
        const long L = (long)i * G + c; if (L >= nwg) return false;
        int wgid = (int)L; { const int q = nwg / NXCD, r = nwg % NXCD, xcd = wgid % NXCD, off = wgid / NXCD; wgid = (xcd < r ? xcd * (q + 1) : r * (q + 1) + (xcd - r) * q) + off; }
        const int nig = WGM * nN, gid = wgid / nig, fm = gid * WGM, gsz = (nM - fm) < WGM ? (nM - fm) : WGM;
        u.pm = fm + ((wgid % nig) % gsz); u.pn = (wgid % nig) / gsz; return true;
    }
    __device__ __forceinline__ void a_ready(const Unit&) const {}
    __device__ __forceinline__ void done(const Unit&) const {}
};

__device__ __forceinline__ unsigned cvt_pk_bf16(float lo, float hi) { unsigned r; asm volatile("v_cvt_pk_bf16_f32 %0, %1, %2" : "=v"(r) : "v"(lo), "v"(hi)); return r; }
typedef float f32x2 __attribute__((ext_vector_type(2)));

__device__ __forceinline__ float sigm(float x) { return __builtin_amdgcn_rcpf(1.f + __builtin_amdgcn_exp2f(-1.4426950408889634f * x)); }
__device__ __forceinline__ float lo16(unsigned w) { return __builtin_bit_cast(float, w << 16); }
__device__ __forceinline__ float hi16(unsigned w) { return __builtin_bit_cast(float, w & 0xffff0000u); }
struct EpiInProj {
    static constexpr bool PERM = true, AFTER_DRAIN = false;
    bf16_t *KA, *VA, *GK, *GV, *QA, *GQ, *GO, *GA, *GG;
    __device__ __forceinline__ void operator()(const f32x4 (&acc)[2][2][4][2], const Unit& u, int wr, int wc, int fr, int fq) const {
        const int pn = u.pn; bf16_t* base; int ldc, colt; float sc = 1.f;
        size_t rowbase;
        if (u.pm < 64) { rowbase = pn < 8 ? (size_t)(u.pm >> 4) * 4352 + 256 + (size_t)(u.pm & 15) * 256 : (size_t)u.pm * 256; }
        else rowbase = (size_t)(u.pm - 64) * 4352;
        if (pn == 0) { base = KA; ldc = 256; colt = 0; }
        else if (pn == 1) { base = VA; ldc = 256; colt = 0; }
        else if (pn < 4) { base = GK; ldc = 512; colt = (pn - 2) * 256; }
        else if (pn < 8) { base = GV; ldc = 1024; colt = (pn - 4) * 256; }
        else if (pn < 12) { base = QA; ldc = 1024; colt = (pn - 8) * 256; }
        else if (pn < 14) { base = GQ; ldc = 512; colt = (pn - 12) * 256; sc = 0.08838834764831845f; }
        else if (pn < 18) { base = GO; ldc = 1024; colt = (pn - 14) * 256; }
        else if (pn < 22) { base = GA; ldc = 1024; colt = (pn - 18) * 256; }
        else { base = GG; ldc = 1024; colt = (pn - 22) * 256; }
        const int col0 = colt + wc * 32 + 8 * fq;
#pragma unroll
        for (int ai = 0; ai < 2; ++ai)
#pragma unroll
            for (int m = 0; m < 4; ++m) { bf16_t* rowp = base + (rowbase + (size_t)(ai * HALF + wr * 64 + m * 16 + fr)) * ldc + col0;
#pragma unroll
                for (int bj = 0; bj < 2; ++bj) { const f32x4 v0 = acc[ai][bj][m][0] * sc, v1 = acc[ai][bj][m][1] * sc;
                    u32x4 w; w.x = cvt_pk_bf16(v0[0], v0[1]); w.y = cvt_pk_bf16(v0[2], v0[3]); w.z = cvt_pk_bf16(v1[0], v1[1]); w.w = cvt_pk_bf16(v1[2], v1[3]);
                    *(u32x4*)(rowp + bj * HALF) = w; } }
    }
};
template <bool FIRST> struct EpiMerge {
    static constexpr bool PERM = true, AFTER_DRAIN = false;
    const bf16_t* G; bf16_t* Y;
    __device__ __forceinline__ void operator()(const f32x4 (&acc)[2][2][4][2], const Unit& u, int wr, int wc, int fr, int fq) const {
        const int row0 = u.pm * BM + wr * 64 + fr, col0 = u.pn * BM + wc * 32 + 8 * fq;
#pragma unroll
        for (int ai = 0; ai < 2; ++ai)
#pragma unroll
            for (int m = 0; m < 4; ++m) { const size_t off = (size_t)(row0 + ai * HALF + m * 16) * 1024 + col0;
#pragma unroll
                for (int bj = 0; bj < 2; ++bj) { const u32x4 g = *(const u32x4*)(G + off + bj * HALF);
                    f32x4 v0 = acc[ai][bj][m][0], v1 = acc[ai][bj][m][1];
                    v0[0] *= sigm(lo16(g.x)); v0[1] *= sigm(hi16(g.x)); v0[2] *= sigm(lo16(g.y)); v0[3] *= sigm(hi16(g.y));
                    v1[0] *= sigm(lo16(g.z)); v1[1] *= sigm(hi16(g.z)); v1[2] *= sigm(lo16(g.w)); v1[3] *= sigm(hi16(g.w));
                    if (!FIRST) { const u32x4 y = *(const u32x4*)(Y + off + bj * HALF);
                        v0[0] += lo16(y.x); v0[1] += hi16(y.x); v0[2] += lo16(y.y); v0[3] += hi16(y.y); v1[0] += lo16(y.z); v1[1] += hi16(y.z); v1[2] += lo16(y.w); v1[3] += hi16(y.w); }
                    u32x4 w; w.x = cvt_pk_bf16(v0[0], v0[1]); w.y = cvt_pk_bf16(v0[2], v0[3]); w.z = cvt_pk_bf16(v1[0], v1[1]); w.w = cvt_pk_bf16(v1[2], v1[3]);
                    *(u32x4*)(Y + off + bj * HALF) = w; } }
    }
};
struct EpiGateRes {
    static constexpr bool PERM = false, AFTER_DRAIN = false;
    const float* base; float* out; const float* gate;
    __device__ __forceinline__ void operator()(const f32x4 (&acc)[2][2][4][2], const Unit& u, int wr, int wc, int fr, int fq) const {
        const int row0 = u.pm * BM + wr * 64 + fr, col0 = u.pn * BM + wc * 32 + 4 * fq;
        const float* gp = gate + (size_t)(u.pm >> 4) * 6144 + col0;
        f32x4 gv[2][2];
#pragma unroll
        for (int bj = 0; bj < 2; ++bj)
#pragma unroll
            for (int n = 0; n < 2; ++n) gv[bj][n] = *(const f32x4*)(gp + bj * HALF + n * 16);
#pragma unroll
        for (int ai = 0; ai < 2; ++ai)
#pragma unroll
            for (int m = 0; m < 4; ++m) { const size_t off = (size_t)(row0 + ai * HALF + m * 16) * 1024 + col0;
#pragma unroll
                for (int bj = 0; bj < 2; ++bj)
#pragma unroll
                    for (int n = 0; n < 2; ++n) { const f32x4 b = *(const f32x4*)(base + off + bj * HALF + n * 16);
                        *(f32x4*)(out + off + bj * HALF + n * 16) = b + gv[bj][n] * acc[ai][bj][m][n]; } }
    }
};
struct EpiSqRelu {
    static constexpr bool PERM = true, AFTER_DRAIN = false;
    bf16_t* H;
    __device__ __forceinline__ void operator()(const f32x4 (&acc)[2][2][4][2], const Unit& u, int wr, int wc, int fr, int fq) const {
        const int row0 = u.pm * BM + wr * 64 + fr, col0 = u.pn * BM + wc * 32 + 8 * fq;
#pragma unroll
        for (int ai = 0; ai < 2; ++ai)
#pragma unroll
            for (int m = 0; m < 4; ++m) { bf16_t* rowp = H + (size_t)(row0 + ai * HALF + m * 16) * 4096 + col0;
#pragma unroll
                for (int bj = 0; bj < 2; ++bj) { f32x4 v0 = acc[ai][bj][m][0], v1 = acc[ai][bj][m][1];
#pragma unroll
                    for (int e = 0; e < 4; ++e) { const float a = __builtin_fmaxf(v0[e], 0.f), b = __builtin_fmaxf(v1[e], 0.f); v0[e] = a * a; v1[e] = b * b; }
                    u32x4 w; w.x = cvt_pk_bf16(v0[0], v0[1]); w.y = cvt_pk_bf16(v0[2], v0[3]); w.z = cvt_pk_bf16(v1[0], v1[1]); w.w = cvt_pk_bf16(v1[2], v1[3]);
                    *(u32x4*)(rowp + bj * HALF) = w; } }
    }
};
struct InOrder {
    StaticOrder so;
    __device__ void init(int G_, int c_) { so.init(16384, 6656, G_, c_); }
    __device__ bool next(int i, Unit& u) const {
        const int L = i * so.G + so.c; if (L >= 1696) return false;
        if (L < 1664) return so.next(i, u);
        const int e = L - 1664; u.pm = 64 + (e >> 3); u.pn = e & 7; return true;
    }
    __device__ __forceinline__ void a_ready(const Unit&) const {}
    __device__ __forceinline__ void done(const Unit&) const {}
};

template <class Epi, class Sched, bool ALIGN_EPI = false, bool SP2 = false>
__device__ __forceinline__ void gemm_phase(PG8_LAS unsigned char* lds, const Gemm g, const Sched& S, const Epi& E) {
    const int tid = threadIdx.x, wid = __builtin_amdgcn_readfirstlane(tid >> 6), lane = tid & 63, wr = wid >> 2, wc = wid & 3, fr = lane & 15, fq = lane >> 4;
    const int K = g.K, nt = K / BK;
    unsigned voffA[2], voffB[2];
#pragma unroll
    for (int i = 0; i < 2; ++i) { int R, C; stage_rc(tid * 16 + i * 8192, R, C); const int Rb = Epi::PERM ? ((R & ~31) + perm32(R & 31)) : R;
        voffA[i] = (unsigned)(R * K + C) * 2u; voffB[i] = (unsigned)(Rb * K + C) * 2u; }
    const size_t kstep = (size_t)(BK * 2);
    const size_t hstep = (size_t)HALF * K * 2;
    const size_t tstep = 2 * hstep;
    const unsigned ldsw = (unsigned)wid * 1024u;
    const int aoff = lds_byte(wr * 64 + fr, fq * 8), boff = lds_byte(wc * 32 + fr, fq * 8);
#define PG8_SA(b, h) (((b) * 2 + (h)) * HTB)
#define PG8_SB(b, h) ((4 + (b) * 2 + (h)) * HTB)
#define PG8_STAGE(bufoff, gbase, voff) do { _Pragma("unroll") for (int _i = 0; _i < 2; ++_i) \
        __builtin_amdgcn_global_load_lds((const unsigned*)((const char*)(gbase) + (voff)[_i]), (PG8_LAS unsigned*)(lds + (bufoff) + ldsw + _i * 8192), 16, 0, 0); } while (0)
#define PG8_LDA(dst, b, h) do { _Pragma("unroll") for (int m = 0; m < 4; ++m) _Pragma("unroll") for (int k = 0; k < 2; ++k) dst[m][k] = *(const PG8_LAS bf16x8*)(lds + PG8_SA(b, h) + aoff + m * 2048 + k * 1024); } while (0)
#define PG8_LDB(dst, b, h) do { _Pragma("unroll") for (int n = 0; n < 2; ++n) _Pragma("unroll") for (int k = 0; k < 2; ++k) dst[n][k] = *(const PG8_LAS bf16x8*)(lds + PG8_SB(b, h) + boff + n * 2048 + k * 1024); } while (0)
#define PG8_MMA(ai, bj, At, Bt) do { __builtin_amdgcn_s_setprio(1); _Pragma("unroll") for (int m = 0; m < 4; ++m) _Pragma("unroll") for (int n = 0; n < 2; ++n) _Pragma("unroll") for (int k = 0; k < 2; ++k) \
        acc[ai][bj][m][n] = __builtin_amdgcn_mfma_f32_16x16x32_bf16(Bt[n][k], At[m][k], acc[ai][bj][m][n], 0, 0, 0); __builtin_amdgcn_s_setprio(0); } while (0)
#define PG8_WAIT_V(n) asm volatile("s_waitcnt vmcnt(" #n ")" ::: "memory")
#define PG8_WAIT_L(n) asm volatile("s_waitcnt lgkmcnt(" #n ")" ::: "memory")
#define PG8_BAR __builtin_amdgcn_s_barrier()
#define PG8_SCHED __builtin_amdgcn_sched_barrier(0)
    Unit cur, nxt; int ui = 0;
    if (!S.next(0, cur)) return;
    f32x4 acc[2][2][4][2];
#pragma unroll
    for (int a = 0; a < 2; ++a)
#pragma unroll
        for (int b = 0; b < 2; ++b)
#pragma unroll
            for (int m = 0; m < 4; ++m)
#pragma unroll
                for (int n = 0; n < 2; ++n) acc[a][b][m][n] = (f32x4){0.f, 0.f, 0.f, 0.f};
    bf16x8 At[4][2], B0[2][2], B1[2][2];
    const char* cA = (const char*)g.A + (size_t)cur.pm * tstep; const char* cB = (const char*)g.Bt + (size_t)cur.pn * tstep;
    S.a_ready(cur);
    if constexpr (SP2) {
        PG8_STAGE(PG8_SB(0, 0), cB, voffB); PG8_STAGE(PG8_SB(0, 1), cB + hstep, voffB); PG8_STAGE(PG8_SA(0, 0), cA, voffA); PG8_STAGE(PG8_SA(0, 1), cA + hstep, voffA);
        if (wr == 1) PG8_BAR;
        PG8_WAIT_V(2); PG8_BAR;
        PG8_STAGE(PG8_SB(1, 0), cB + kstep, voffB); PG8_STAGE(PG8_SA(1, 0), cA + kstep, voffA); PG8_STAGE(PG8_SB(1, 1), cB + hstep + kstep, voffB);
        PG8_WAIT_V(6); PG8_BAR;
    } else {
        PG8_STAGE(PG8_SB(0, 0), cB, voffB); PG8_STAGE(PG8_SA(0, 0), cA, voffA); PG8_STAGE(PG8_SB(0, 1), cB + hstep, voffB); PG8_STAGE(PG8_SA(0, 1), cA + hstep, voffA);
        if (wr == 1) PG8_BAR;
        PG8_WAIT_V(4); PG8_BAR;
        PG8_STAGE(PG8_SB(1, 0), cB + kstep, voffB); PG8_STAGE(PG8_SA(1, 0), cA + kstep, voffA); PG8_STAGE(PG8_SB(1, 1), cB + hstep + kstep, voffB);
        PG8_WAIT_V(6); PG8_BAR;
    }
    for (;;) {
        const bool has_next = S.next(ui + 1, nxt);
        const char* nA = has_next ? (const char*)g.A + (size_t)nxt.pm * tstep : cA; const char* nB = has_next ? (const char*)g.Bt + (size_t)nxt.pn * tstep : cB;
        for (int t = 0; t < nt; t += 2) {
            const bool last = (t == nt - 2);
            const char* a1 = cA + (size_t)(t + 1) * kstep;
            const char* a2 = last ? nA : cA + (size_t)(t + 2) * kstep; const char* b2 = last ? nB : cB + (size_t)(t + 2) * kstep;
            const char* a3 = a2 + kstep; const char* b3 = b2 + kstep;
            if (last && has_next) S.a_ready(nxt);
            if constexpr (SP2) {
            PG8_LDB(B0, 0, 0); PG8_LDB(B1, 0, 1); PG8_SCHED; PG8_LDA(At, 0, 0); PG8_STAGE(PG8_SA(1, 1), a1 + hstep, voffA);
            PG8_WAIT_V(8); PG8_WAIT_L(0); PG8_BAR; PG8_MMA(0, 0, At, B0); PG8_MMA(0, 1, At, B1); PG8_BAR; PG8_SCHED;
            PG8_LDA(At, 0, 1); PG8_STAGE(PG8_SB(0, 0), b2, voffB); PG8_STAGE(PG8_SB(0, 1), b2 + hstep, voffB); PG8_STAGE(PG8_SA(0, 0), a2, voffA);
            PG8_WAIT_V(8); PG8_WAIT_L(0); PG8_BAR; PG8_MMA(1, 0, At, B0); PG8_MMA(1, 1, At, B1); PG8_BAR; PG8_SCHED;
            PG8_LDB(B0, 1, 0); PG8_LDB(B1, 1, 1); PG8_SCHED; PG8_LDA(At, 1, 0); PG8_STAGE(PG8_SA(0, 1), a2 + hstep, voffA);
            PG8_WAIT_V(8); PG8_WAIT_L(0); PG8_BAR; PG8_MMA(0, 0, At, B0); PG8_MMA(0, 1, At, B1); PG8_BAR; PG8_SCHED;
            PG8_LDA(At, 1, 1); PG8_STAGE(PG8_SB(1, 0), b3, voffB); PG8_STAGE(PG8_SB(1, 1), b3 + hstep, voffB); PG8_STAGE(PG8_SA(1, 0), a3, voffA);
            PG8_WAIT_V(8); PG8_WAIT_L(0); PG8_BAR; PG8_MMA(1, 0, At, B0); PG8_MMA(1, 1, At, B1); PG8_BAR; PG8_SCHED;
            } else {
            PG8_LDB(B0, 0, 0); PG8_SCHED; PG8_LDA(At, 0, 0); PG8_STAGE(PG8_SA(1, 1), a1 + hstep, voffA);
            PG8_WAIT_L(8); PG8_BAR; PG8_WAIT_L(0); PG8_MMA(0, 0, At, B0); PG8_BAR; PG8_SCHED;
            PG8_LDB(B1, 0, 1); PG8_STAGE(PG8_SB(0, 0), b2, voffB);
            PG8_BAR; PG8_WAIT_L(0); PG8_MMA(0, 1, At, B1); PG8_BAR;
            PG8_LDA(At, 0, 1); PG8_STAGE(PG8_SA(0, 0), a2, voffA);
            PG8_BAR; PG8_WAIT_L(0); PG8_MMA(1, 0, At, B0); PG8_BAR; PG8_SCHED;
            PG8_STAGE(PG8_SB(0, 1), b2 + hstep, voffB);
            PG8_WAIT_V(6); PG8_BAR; PG8_MMA(1, 1, At, B1); PG8_BAR;
            PG8_LDB(B0, 1, 0); PG8_SCHED; PG8_LDA(At, 1, 0); PG8_STAGE(PG8_SA(0, 1), a2 + hstep, voffA);
            PG8_WAIT_L(8); PG8_BAR; PG8_WAIT_L(0); PG8_MMA(0, 0, At, B0); PG8_BAR; PG8_SCHED;
            PG8_LDB(B1, 1, 1); PG8_STAGE(PG8_SB(1, 0), b3, voffB);
            PG8_BAR; PG8_WAIT_L(0); PG8_MMA(0, 1, At, B1); PG8_BAR;
            PG8_LDA(At, 1, 1); PG8_STAGE(PG8_SA(1, 0), a3, voffA);
            PG8_BAR; PG8_WAIT_L(0); PG8_MMA(1, 0, At, B0); PG8_BAR; PG8_SCHED;
            PG8_STAGE(PG8_SB(1, 1), b3 + hstep, voffB);
            PG8_WAIT_V(6); PG8_BAR; PG8_MMA(1, 1, At, B1); PG8_BAR;
            }
        }
        if constexpr (ALIGN_EPI) { if (wr == 0) PG8_BAR; }
        if constexpr (!Epi::AFTER_DRAIN) { E(acc, cur, wr, wc, fr, fq); S.done(cur); }
        if (!has_next) break;
#pragma unroll
        for (int a = 0; a < 2; ++a)
#pragma unroll
            for (int b = 0; b < 2; ++b)
#pragma unroll
                for (int m = 0; m < 4; ++m)
#pragma unroll
                    for (int n = 0; n < 2; ++n) acc[a][b][m][n] = (f32x4){0.f, 0.f, 0.f, 0.f};
        cur = nxt; cA = nA; cB = nB; ++ui;
        if constexpr (ALIGN_EPI) { if (wr == 1) PG8_BAR; }
    }
    PG8_WAIT_V(0);
    if constexpr (!ALIGN_EPI) { if (wr == 0) PG8_BAR; }
    PG8_BAR;
    if constexpr (Epi::AFTER_DRAIN) { E.fused(acc, cur, wr, wc, fr, fq, lds, wid, lane); S.done(cur); }
#undef PG8_SA
#undef PG8_SB
#undef PG8_STAGE
#undef PG8_LDA
#undef PG8_LDB
#undef PG8_MMA
#undef PG8_WAIT_V
#undef PG8_WAIT_L
#undef PG8_BAR
#undef PG8_SCHED
}
}
#define GAS __attribute__((address_space(1)))
#define LAS __attribute__((address_space(3)))
typedef unsigned short bf16;
typedef unsigned v4u __attribute__((ext_vector_type(4)));
typedef float f32x4 __attribute__((ext_vector_type(4)));
typedef short bf16x8 __attribute__((ext_vector_type(8)));
typedef GAS unsigned gu32;
typedef GAS unsigned long long gu64;
#define RLX_AGENT __ATOMIC_RELAXED, __HIP_MEMORY_SCOPE_AGENT
#define LDS_WAIT() asm volatile("s_waitcnt lgkmcnt(0)" ::: "memory")
#define VM_WAIT() asm volatile("s_waitcnt vmcnt(0)" ::: "memory")
__device__ __forceinline__ unsigned long long rt() { return __builtin_amdgcn_s_memrealtime(); }
__device__ __forceinline__ unsigned pk2(float lo, float hi) { return f2bf(lo) | (f2bf(hi) << 16); }

#define XB_TMO      128
#define XB_XCNT(j)  (256  + 64 * (j))
#define XB_XSUB(j)  (1280 + 64 * (j))
#define XB_XGEN(j)  (2304 + 64 * (j))
#define XB_TOP      3328
#define XB_TOPGEN   3392
#define XCD_BAR_WORDS 3456
#define XB_SPIN_CAP (1u << 18)

__device__ __forceinline__ unsigned xb_ld(unsigned* p)              { return __hip_atomic_load(p, __ATOMIC_RELAXED, __HIP_MEMORY_SCOPE_AGENT); }
__device__ __forceinline__ unsigned xb_add(unsigned* p, unsigned v) { return __hip_atomic_fetch_add(p, v, __ATOMIC_RELAXED, __HIP_MEMORY_SCOPE_AGENT); }
__device__ __forceinline__ unsigned xb_xcc_id() { return (unsigned)__builtin_amdgcn_s_getreg((3 << 11) | 20) & 0xFu; }
#define XB_SPIN(cond, bar) do { unsigned _sp = 0; while (cond) { __builtin_amdgcn_s_sleep(1); \
    if ((++_sp & 255u) == 0u) { if (xb_ld(&(bar)[XB_TMO])) break; if (_sp > XB_SPIN_CAP) { atomicAdd(&(bar)[XB_TMO], 1u); break; } } } } while (0)

struct XcdBarrier {
    unsigned* bar; unsigned x;
    volatile LAS unsigned* st;
};

__device__ __forceinline__ XcdBarrier xcd_barrier_post(unsigned* bar, volatile LAS unsigned* st) {
    XcdBarrier b; b.bar = bar; b.x = xb_xcc_id(); b.st = st;
    if (threadIdx.x == 0) (void)xb_add(&bar[XB_XCNT(b.x)], 1u);
    return b;
}
__device__ __forceinline__ void xcd_barrier_complete(unsigned* bar, unsigned x, unsigned& nloc, unsigned& nx) {
    const unsigned G = gridDim.x * gridDim.y * gridDim.z;
    unsigned sum, cnt, mine, sp = 0u;
    for (;;) {
        sum = 0u; cnt = 0u; mine = 0u;
#pragma unroll
        for (unsigned j = 0; j < 16; ++j) { const unsigned c = xb_ld(&bar[XB_XCNT(j)]); sum += c; cnt += (c > 0u) ? 1u : 0u; mine = (j == x) ? c : mine; }
        if (sum == G) break;
        __builtin_amdgcn_s_sleep(1);
        if ((++sp & 255u) == 0u) { if (xb_ld(&bar[XB_TMO])) break; if (sp > XB_SPIN_CAP) { atomicAdd(&bar[XB_TMO], 1u); break; } }
    }
    nloc = mine > 0u ? mine : 1u; nx = cnt > 0u ? cnt : 1u;
}

__device__ __forceinline__ void xcd_barrier(const XcdBarrier& b) {
    asm volatile("s_waitcnt vmcnt(0)" ::: "memory");
    __syncthreads();
    if (threadIdx.x == 0) {
        unsigned* bar = b.bar;
        __builtin_amdgcn_s_waitcnt(0);
        unsigned nloc = b.st[0], nx = b.st[1];
        if (nloc == 0u) { xcd_barrier_complete(bar, b.x, nloc, nx); b.st[0] = nloc; b.st[1] = nx; }
        const unsigned old = xb_add(&bar[XB_XSUB(b.x)], 1u);
        const unsigned gen = old / nloc;
        if (old + 1u == (gen + 1u) * nloc) {
            __builtin_amdgcn_fence(__ATOMIC_RELEASE, "agent");
            asm volatile("s_waitcnt vmcnt(0)" ::: "memory");
            const unsigned og = xb_add(&bar[XB_TOP], 1u);
            const unsigned tg = og / nx;
            if (og + 1u == (tg + 1u) * nx) xb_add(&bar[XB_TOPGEN], 1u);
            else XB_SPIN(xb_ld(&bar[XB_TOPGEN]) == tg, bar);
            __builtin_amdgcn_fence(__ATOMIC_ACQUIRE, "agent");
            xb_add(&bar[XB_XGEN(b.x)], 1u);
            asm volatile("s_waitcnt vmcnt(0)" ::: "memory");
        } else {
            XB_SPIN(xb_ld(&bar[XB_XGEN(b.x)]) == gen, bar);
            __builtin_amdgcn_fence(__ATOMIC_ACQUIRE, "agent");
            asm volatile("s_waitcnt vmcnt(0)" ::: "memory");
        }
    }
    __syncthreads();
}

namespace att {
using bf16 = unsigned short;
constexpr int   D = 128, NW = 8, QBLK = 32, KVBLK = 64;
constexpr float SCALE = 0.088388347648318440f;
constexpr float THR = 8.f;
constexpr int SDEPTH = 2;
constexpr int LDQ = 1024, LDK = 256, LDO = 1024;
constexpr size_t SHM_V = KVBLK * D * 2, SHM_K = KVBLK * D * 2, SHM_ATTN = 2 * SHM_V + 2 * SHM_K + NW * 64 * 4;
using s16x4  = __attribute__((ext_vector_type(4))) short;
using f32x8  = __attribute__((ext_vector_type(8))) float;
using bf16x8 = __attribute__((ext_vector_type(8))) short;
using s16x4  = __attribute__((ext_vector_type(4))) short;
using f32x16 = __attribute__((ext_vector_type(16))) float;
using f32x8  = __attribute__((ext_vector_type(8))) float;
using u32x4  = __attribute__((ext_vector_type(4))) unsigned;
#define KSWZ(row, colB) ((row) * 256 + ((colB) ^ (((row) & 7) << 4)))
#define SBAR() __builtin_amdgcn_sched_barrier(0)
__device__ __forceinline__ unsigned cvtpk(float lo, float hi) {
  unsigned r; asm volatile("v_cvt_pk_bf16_f32 %0, %1, %2" : "=v"(r) : "v"(lo), "v"(hi)); return r;
}
template <typename TIn> struct Stage;
template <> struct Stage<bf16>  { using T = bf16x8;
  __device__ static __forceinline__ T ld8(const bf16* p) { return *reinterpret_cast<const bf16x8*>(p); }
  __device__ static __forceinline__ bf16x8 tobf(T x) { return x; } };
__device__ __forceinline__ void partialSM(f32x16& p0, f32x16& p1, float& m_reg, float& mn, float& alpha) {
  constexpr float C = SCALE * 1.4426950408889634f;
  float pmax = p0[0]; for (int r = 1; r < 16; ++r) pmax = fmaxf(pmax, p0[r]); for (int r = 0; r < 16; ++r) pmax = fmaxf(pmax, p1[r]);
  { auto rr = __builtin_amdgcn_permlane32_swap(__float_as_uint(pmax), __float_as_uint(pmax), false, false);
    pmax = fmaxf(__uint_as_float(rr[0]), __uint_as_float(rr[1])); }
  if (__builtin_expect(__all(pmax - m_reg <= THR / SCALE), 1)) { mn = m_reg; alpha = 1.f; }
  else { mn = fmaxf(m_reg, pmax); alpha = __builtin_amdgcn_exp2f((m_reg - mn) * C); m_reg = mn; }
  float mnC = -mn * C;
  for (int r = 0; r < 16; ++r) p0[r] = fmaf(p0[r], C, mnC); for (int r = 0; r < 16; ++r) p1[r] = fmaf(p1[r], C, mnC);
  for (int r = 0; r < 16; ++r) p0[r] = __builtin_amdgcn_exp2f(p0[r]);
}
__device__ __forceinline__ void finishSM(f32x16& p0, f32x16& p1, float alpha, float& l_reg, bf16x8& pa0, bf16x8& pa1, bf16x8& pa2, bf16x8& pa3) {
  for (int r = 0; r < 16; ++r) p1[r] = __builtin_amdgcn_exp2f(p1[r]);
  float ps = 0; for (int r = 0; r < 16; ++r) ps += p0[r]; for (int r = 0; r < 16; ++r) ps += p1[r];
  { auto rr = __builtin_amdgcn_permlane32_swap(__float_as_uint(ps), __float_as_uint(ps), false, false);
    ps = __uint_as_float(rr[0]) + __uint_as_float(rr[1]); }
  l_reg = l_reg * alpha + ps;
#define PK4(P, BASE, OUT) do { unsigned a0 = cvtpk(P[BASE + 0], P[BASE + 1]), a1 = cvtpk(P[BASE + 2], P[BASE + 3]);   \
    unsigned b0 = cvtpk(P[BASE + 4], P[BASE + 5]), b1 = cvtpk(P[BASE + 6], P[BASE + 7]);                              \
    auto r0 = __builtin_amdgcn_permlane32_swap(a0, b0, false, false); auto r1 = __builtin_amdgcn_permlane32_swap(a1, b1, false, false); \
    u32x4 w = {r0[0], r1[0], r0[1], r1[1]}; OUT = *reinterpret_cast<bf16x8*>(&w); } while (0)
  PK4(p0, 0, pa0); PK4(p0, 8, pa1); PK4(p1, 0, pa2); PK4(p1, 8, pa3);
#undef PK4
}
__device__ __forceinline__ void qkt(f32x16& p0, f32x16& p1, const bf16* Ks, const bf16x8* qr, int r32, int hi) {
  p0 = f32x16{}; p1 = f32x16{};
  for (int d0 = 0; d0 < 8; ++d0) { int cb = (d0 * 16 + hi * 8) * 2;
    bf16x8 b0 = *reinterpret_cast<const bf16x8*>((const char*)Ks + KSWZ(r32, cb));
    bf16x8 b1 = *reinterpret_cast<const bf16x8*>((const char*)Ks + KSWZ(32 + r32, cb));
    p0 = __builtin_amdgcn_mfma_f32_32x32x16_bf16(b0, qr[d0], p0, 0, 0, 0);
    p1 = __builtin_amdgcn_mfma_f32_32x32x16_bf16(b1, qr[d0], p1, 0, 0, 0); }
}
__device__ __forceinline__ int v_st(int k, int c) { const int kk = (k & ~0xC) | ((k & 4) << 1) | ((k & 8) >> 1); return ((kk >> 3) * 4 + (c >> 5)) * 512 + ((kk & 7) * 32 + (c & 31)) * 2; }
__device__ __forceinline__ int v_rd_base(int lane) { return ((lane & 3) << 3) | (((lane >> 2) & 3) << 6) | (((lane >> 4) & 1) << 5) | (((lane >> 5) & 1) << 8); }
constexpr int v_rd_off(int d0, int ks, int half) { return d0 * 512 + ks * 4096 + half * 2048; }
template <int OFF> __device__ __forceinline__ s16x4 tr_read(int vb) {
  s16x4 r; asm volatile("ds_read_b64_tr_b16 %0, %1 offset:%2" : "=&v"(r) : "v"(vb), "i"(OFF) : "memory"); return r;
}
template <int D0> __device__ __forceinline__ void pv_one(f32x16& od, int vb, bf16x8 pa0, bf16x8 pa1, bf16x8 pa2, bf16x8 pa3) {
  const s16x4 l0 = tr_read<v_rd_off(D0, 0, 0)>(vb), h0 = tr_read<v_rd_off(D0, 0, 1)>(vb), l1 = tr_read<v_rd_off(D0, 1, 0)>(vb), h1 = tr_read<v_rd_off(D0, 1, 1)>(vb);
  const s16x4 l2 = tr_read<v_rd_off(D0, 2, 0)>(vb), h2 = tr_read<v_rd_off(D0, 2, 1)>(vb), l3 = tr_read<v_rd_off(D0, 3, 0)>(vb), h3 = tr_read<v_rd_off(D0, 3, 1)>(vb);
  asm volatile("s_waitcnt lgkmcnt(0)" ::: "memory"); SBAR();
#define PK(L, H) (bf16x8){L[0], L[1], L[2], L[3], H[0], H[1], H[2], H[3]}
  od = __builtin_amdgcn_mfma_f32_32x32x16_bf16(pa0, PK(l0, h0), od, 0, 0, 0);
  od = __builtin_amdgcn_mfma_f32_32x32x16_bf16(pa1, PK(l1, h1), od, 0, 0, 0);
  od = __builtin_amdgcn_mfma_f32_32x32x16_bf16(pa2, PK(l2, h2), od, 0, 0, 0);
  od = __builtin_amdgcn_mfma_f32_32x32x16_bf16(pa3, PK(l3, h3), od, 0, 0, 0);
#undef PK
}
__device__ __forceinline__ void pv_d0(f32x16* o, int vb, bf16x8 pa0, bf16x8 pa1, bf16x8 pa2, bf16x8 pa3) {
  pv_one<0>(o[0], vb, pa0, pa1, pa2, pa3); pv_one<1>(o[1], vb, pa0, pa1, pa2, pa3); pv_one<2>(o[2], vb, pa0, pa1, pa2, pa3); pv_one<3>(o[3], vb, pa0, pa1, pa2, pa3);
}

template <typename TQ>
__device__ __forceinline__ void attn_dense_body(const TQ* Qb, const bf16* __restrict__ Kh, const bf16* __restrict__ Vh,
                                                bf16* Ob, int seq, char* lds) {
  using St = Stage<bf16>; using SQ = Stage<TQ>;
  const int tid = threadIdx.x, wid = tid >> 6, lane = tid & 63, r32 = lane & 31, hi = lane >> 5;
  bf16* V_lds = (bf16*)lds; bf16* K_lds = (bf16*)(lds + 2 * SHM_V);
  float* ws = (float*)(lds + 2 * SHM_V + 2 * SHM_K) + wid * 64; float* li_l = ws; float* al_l = ws + 32;
  float m_reg = -1e30f, l_reg = 0; f32x16 o[4] = {}; bf16x8 qr[8];
  const TQ* Qw = Qb + (long)(wid * QBLK + r32) * LDQ + hi * 8;
#pragma unroll
  for (int d0 = 0; d0 < 8; ++d0) qr[d0] = SQ::tobf(SQ::ld8(Qw + d0 * 16));
  const int sr = tid >> 4, sc = (tid & 15) * 8, vst0 = v_st(sr, sc), vst1 = v_st(32 + sr, sc);
  const int vb0 = (int)(uintptr_t)V_lds + v_rd_base(lane);
  struct { typename St::T vs0, vs1, ks0, ks1; } sr_[SDEPTH];
#define SLOAD(i, k0) do { sr_[i].vs0 = St::ld8(&Vh[(long)((k0) + sr) * LDK + sc]); sr_[i].vs1 = St::ld8(&Vh[(long)((k0) + 32 + sr) * LDK + sc]); \
    sr_[i].ks0 = St::ld8(&Kh[(long)((k0) + sr) * LDK + sc]); sr_[i].ks1 = St::ld8(&Kh[(long)((k0) + 32 + sr) * LDK + sc]); } while (0)
#define SWRITE(b, i) do { *(bf16x8*)((char*)V_lds + (b) * SHM_V + vst0) = St::tobf(sr_[i].vs0);          \
    *(bf16x8*)((char*)V_lds + (b) * SHM_V + vst1) = St::tobf(sr_[i].vs1); int kc = sc * 2;               \
    *(bf16x8*)((char*)K_lds + (b) * SHM_K + KSWZ(sr, kc)) = St::tobf(sr_[i].ks0);                       \
    *(bf16x8*)((char*)K_lds + (b) * SHM_K + KSWZ(32 + sr, kc)) = St::tobf(sr_[i].ks1); } while (0)
#define SWAIT() do { if constexpr (SDEPTH == 2) asm volatile("s_waitcnt vmcnt(4)" ::: "memory"); else asm volatile("s_waitcnt vmcnt(0)" ::: "memory"); } while (0)
#define RESC(a) do { if (__any((a) < 1.f)) { if (hi == 0) al_l[r32] = (a); asm volatile("s_waitcnt lgkmcnt(0)" ::: "memory"); \
    for (int d = 0; d < 4; ++d) for (int r = 0; r < 16; ++r) o[d][r] *= al_l[crow(r, hi)]; } } while (0)
  f32x16 pA0, pA1, pB0, pB1; float mnA, mnB, alA, alB; bf16x8 pa0, pa1, pa2, pa3; const int NT = seq / KVBLK;
  constexpr int SE = 0, SO = SDEPTH - 1;
  SLOAD(SE, 0); asm volatile("s_waitcnt vmcnt(0)" ::: "memory"); SWRITE(0, SE); __syncthreads();
  qkt(pA0, pA1, K_lds, qr, r32, hi); partialSM(pA0, pA1, m_reg, mnA, alA);
  SLOAD(SO, KVBLK); if constexpr (SDEPTH == 2) { if (2 < NT) SLOAD(SE, 2 * KVBLK); }
  SWAIT(); SWRITE(1, SO); __syncthreads();
  for (int j = 1; j + 1 < NT; j += 2) {
    SBAR(); qkt(pB0, pB1, (bf16*)((char*)K_lds + SHM_K), qr, r32, hi);
    finishSM(pA0, pA1, alA, l_reg, pa0, pa1, pa2, pa3); SBAR();
    SLOAD(SO, (j + SDEPTH) * KVBLK); SBAR();
    pv_d0(o, vb0, pa0, pa1, pa2, pa3); partialSM(pB0, pB1, m_reg, mnB, alB);
    __syncthreads(); SWAIT(); SWRITE(0, SE);
    RESC(alB); __syncthreads();
    SBAR(); qkt(pA0, pA1, K_lds, qr, r32, hi);
    finishSM(pB0, pB1, alB, l_reg, pa0, pa1, pa2, pa3); SBAR();
    if (SDEPTH == 1 || j + 3 < NT) SLOAD(SE, (j + 1 + SDEPTH) * KVBLK); SBAR();
    pv_d0(o, vb0 + (int)SHM_V, pa0, pa1, pa2, pa3); partialSM(pA0, pA1, m_reg, mnA, alA);
    __syncthreads(); SWAIT(); SWRITE(1, SO);
    RESC(alA); __syncthreads();
  }
  SBAR(); qkt(pB0, pB1, (bf16*)((char*)K_lds + SHM_K), qr, r32, hi);
  finishSM(pA0, pA1, alA, l_reg, pa0, pa1, pa2, pa3); SBAR();
  pv_d0(o, vb0, pa0, pa1, pa2, pa3); partialSM(pB0, pB1, m_reg, mnB, alB);
  __syncthreads(); RESC(alB);
  finishSM(pB0, pB1, alB, l_reg, pa0, pa1, pa2, pa3); SBAR();
  pv_d0(o, vb0 + (int)SHM_V, pa0, pa1, pa2, pa3);
  if (hi == 0) li_l[r32] = l_reg; asm volatile("s_waitcnt lgkmcnt(0)" ::: "memory");
  float rli[16];
#pragma unroll
  for (int r = 0; r < 16; ++r) rli[r] = __builtin_amdgcn_rcpf(li_l[crow(r, hi)]);
  bf16* Ow = Ob + (long)(wid * QBLK) * LDO;
#pragma unroll
  for (int r = 0; r < 16; ++r) { int orow = crow(r, hi);
#pragma unroll
    for (int d0 = 0; d0 < 4; ++d0) Ow[(long)orow * LDO + d0 * 32 + r32] = (bf16)f2bf(o[d0][r] * rli[r]); }
  __syncthreads();
#undef SLOAD
#undef SWRITE
#undef SWAIT
#undef RESC
}
#undef KSWZ
#undef SBAR
}

namespace gla {
typedef __attribute__((address_space(3))) unsigned char* lptr;
typedef __attribute__((address_space(3))) const char* lds_cptr;
typedef short v4i16_t __attribute__((ext_vector_type(4)));
typedef short s16x4 __attribute__((ext_vector_type(4)));
__device__ __forceinline__ s16x4 vtr(lds_cptr p) { return __builtin_bit_cast(s16x4, __builtin_amdgcn_ds_read_tr16_b64_v4i16((__attribute__((address_space(3))) v4i16_t*)p)); }
__device__ __forceinline__ unsigned cvtpk(float lo, float hi) { unsigned r; asm volatile("v_cvt_pk_bf16_f32 %0, %1, %2" : "=v"(r) : "v"(lo), "v"(hi)); return r; }
__device__ __forceinline__ float logsig16(float x) {
    const float e = __builtin_amdgcn_exp2f(-__builtin_fabsf(x) * 1.4426950408889634f);
    const float l = __builtin_amdgcn_logf(1.f + e) * 0.6931471805599453f;
    return (__builtin_fminf(x, 0.f) - l) * 0.0625f;
}
__device__ __forceinline__ float expf_(float x) { return __builtin_amdgcn_exp2f(x * 1.4426950408889634f); }

struct Ptrs {
    bf16_t* GK; const bf16_t* GV; bf16_t* GQ; bf16_t* QEB; bf16_t* KDB; float* GAM; bf16_t* AM; bf16_t* OI; bf16_t* OIB; bf16_t* GO; const float* LR;
    const float *w_gk_f, *b_gk_f, *w_gk_b, *b_gk_b, *gla_norm;
};

constexpr int G1_LR = 0, G1_TOT = 8192, G1_QE = 12288, G1_PITCH = 136, G1_KE = G1_QE + 2 * 64 * G1_PITCH * 2;
static_assert(G1_KE + 2 * 64 * G1_PITCH * 2 <= 131072, "G1 LDS");

__device__ __forceinline__ void g1_unit(const Ptrs& p, int bh, int ci, lptr lds, int tid) {
    const int b = bh >> 2, h = bh & 3, d = tid & 127, tq = tid >> 7;
    const size_t pr0 = (size_t)b * P + (size_t)ci * 64;
    const bool isx = ci >= 4; const size_t m0 = (size_t)b * T + (size_t)(ci - 4) * 64;
    __attribute__((address_space(3))) float* LRs = (__attribute__((address_space(3))) float*)(lds + G1_LR);
    __attribute__((address_space(3))) float* TOT = (__attribute__((address_space(3))) float*)(lds + G1_TOT);
    __attribute__((address_space(3))) bf16_t* QEs = (__attribute__((address_space(3))) bf16_t*)(lds + G1_QE);
    __attribute__((address_space(3))) bf16_t* KEs = (__attribute__((address_space(3))) bf16_t*)(lds + G1_KE);
    { const f32x4 v = *(const f32x4*)(p.LR + (pr0 + (tid >> 3)) * 32 + (tid & 7) * 4); *(__attribute__((address_space(3))) f32x4*)(LRs + (tid >> 3) * 32 + (tid & 7) * 4) = v; }
    float kv[16], qv[16];
#pragma unroll
    for (int i = 0; i < 16; ++i) kv[i] = bf2f(p.GK[(pr0 + 16 * tq + i) * 512 + h * 128 + d]);
#pragma unroll
    for (int i = 0; i < 16; ++i) qv[i] = isx ? bf2f(p.GQ[(m0 + 16 * tq + i) * 512 + h * 128 + d]) : 0.f;
    asm volatile("s_waitcnt vmcnt(0)" ::: "memory");
    __syncthreads();
    float cs[2][16];
#pragma unroll
    for (int dir = 0; dir < 2; ++dir) {
        const float* wg = dir ? p.w_gk_b : p.w_gk_f; const float bias = (dir ? p.b_gk_b : p.b_gk_f)[h * 128 + d];
        float w[16];
#pragma unroll
        for (int r = 0; r < 16; ++r) w[r] = wg[r * 512 + h * 128 + d];
        float g[16];
#pragma unroll
        for (int i = 0; i < 16; ++i) { float x = bias;
#pragma unroll
            for (int r = 0; r < 16; ++r) x += LRs[(16 * tq + i) * 32 + dir * 16 + r] * w[r];
            g[i] = logsig16(x); }
        float run = 0.f;
        if (dir == 0) {
#pragma unroll
            for (int i = 0; i < 16; ++i) { run += g[i]; cs[0][i] = run; }
        } else {
#pragma unroll
            for (int i = 15; i >= 0; --i) { run += g[i]; cs[1][i] = run; }
        }
        TOT[(dir * 4 + tq) * 128 + d] = run;
    }
    __syncthreads();
#pragma unroll
    for (int dir = 0; dir < 2; ++dir) {
        const float t0 = TOT[(dir * 4 + 0) * 128 + d], t1 = TOT[(dir * 4 + 1) * 128 + d], t2 = TOT[(dir * 4 + 2) * 128 + d], t3 = TOT[(dir * 4 + 3) * 128 + d];
        const float btot = (t0 + t1) + (t2 + t3);
        float off;
        if (dir == 0) off = (tq > 0 ? t0 : 0.f) + (tq > 1 ? t1 : 0.f) + (tq > 2 ? t2 : 0.f);
        else          off = (tq < 1 ? t1 : 0.f) + (tq < 2 ? t2 : 0.f) + (tq < 3 ? t3 : 0.f);
        unsigned kdw[8];
#pragma unroll
        for (int i = 0; i < 16; i += 2) { const float b0 = off + cs[dir][i], b1 = off + cs[dir][i + 1];
            kdw[i >> 1] = cvtpk(kv[i] * expf_(btot - b0), kv[i + 1] * expf_(btot - b1)); }
        bf16_t* kdp = dir == 0 ? p.GK + (pr0 + (size_t)(d >> 1)) * 512 + h * 128 + (d & 1) * 64 + 16 * tq
                               : p.KDB + (((size_t)bh * NCH + ci) * 128 + d) * 64 + 16 * tq;
        *(u32x4*)kdp = (u32x4){kdw[0], kdw[1], kdw[2], kdw[3]}; *(u32x4*)(kdp + 8) = (u32x4){kdw[4], kdw[5], kdw[6], kdw[7]};
        if (tq == 0) p.GAM[(((size_t)dir * 16 + bh) * NCH + ci) * 128 + d] = expf_(btot);
        if (isx) {
            bf16_t* qdst = (dir == 0 ? p.GQ : p.QEB) + (m0 + 16 * tq) * 512 + h * 128 + d;
#pragma unroll
            for (int i = 0; i < 16; ++i) { const float bi = off + cs[dir][i];
                const bf16_t qe = (bf16_t)f2bf(qv[i] * expf_(bi)), ke = (bf16_t)f2bf(kv[i] * expf_(-bi));
                qdst[(size_t)i * 512] = qe;
                QEs[(dir * 64 + 16 * tq + i) * G1_PITCH + d] = qe; KEs[(dir * 64 + 16 * tq + i) * G1_PITCH + d] = ke; }
        }
    }
    __syncthreads();
    if (isx) {
        const int wave = tid >> 6, lane = tid & 63, fr = lane & 15, fq = lane >> 4, ti = wave >> 1;
        bf16_t* am = p.AM + ((size_t)bh * 64 + (ci - 4)) * 4096;
#pragma unroll
        for (int jj = 0; jj < 2; ++jj) { const int tj = 2 * (wave & 1) + jj;
            f32x4 aF = {0.f, 0.f, 0.f, 0.f}, aB = {0.f, 0.f, 0.f, 0.f};
#pragma unroll
            for (int ks = 0; ks < 4; ++ks) {
                const bf16x8 qf = *(const __attribute__((address_space(3))) bf16x8*)(QEs + (16 * ti + fr) * G1_PITCH + 32 * ks + 8 * fq);
                const bf16x8 kf = *(const __attribute__((address_space(3))) bf16x8*)(KEs + (16 * tj + fr) * G1_PITCH + 32 * ks + 8 * fq);
                const bf16x8 qb = *(const __attribute__((address_space(3))) bf16x8*)(QEs + (64 + 16 * ti + fr) * G1_PITCH + 32 * ks + 8 * fq);
                const bf16x8 kb = *(const __attribute__((address_space(3))) bf16x8*)(KEs + (64 + 16 * tj + fr) * G1_PITCH + 32 * ks + 8 * fq);
                aF = __builtin_amdgcn_mfma_f32_16x16x32_bf16(qf, kf, aF, 0, 0, 0);
                aB = __builtin_amdgcn_mfma_f32_16x16x32_bf16(qb, kb, aB, 0, 0, 0);
            }
#pragma unroll
            for (int r = 0; r < 4; ++r) { const int i = 16 * ti + 4 * fq + r, j = 16 * tj + fr;
                const float v = (j <= i ? aF[r] : 0.f) + (j >= i ? aB[r] : 0.f);
                am[i * 64 + j] = (bf16_t)f2bf(v); }
        }
    }
    __syncthreads();
}

constexpr int G2_OPB = 34816, G2_QE = 0, G2_KD = 16384, G2_V = 32768;
constexpr int G2_ST = 4 * G2_OPB, G2_STP = 136;
static_assert(G2_ST + 4 * 16 * G2_STP * 2 <= 163328, "G2 LDS");
struct G2Stage { u32x4 q[4], k[4], v; f32x4 g0, g1; };
template <int dir> __device__ __forceinline__ void g2_load(const Ptrs& p, G2Stage& st, int s, int wq, int bh, int dvb, int lane) {
    const int b = bh >> 2, h = bh & 3;
    const int ci = dir == 0 ? s : (s < 4 ? 3 - s : 71 - s);
    const size_t pr0 = (size_t)b * P + (size_t)ci * 64;
    if (ci >= 4) { const size_t m0 = (size_t)b * T + (size_t)(ci - 4) * 64; const bf16_t* qb = (dir == 0 ? p.GQ : p.QEB) + m0 * 512 + h * 128;
#pragma unroll
        for (int k = 0; k < 4; ++k) { const int row = 4 * (wq + 4 * k) + (lane >> 4); st.q[k] = *(const u32x4*)(qb + (size_t)row * 512 + (lane & 15) * 8); } }
#pragma unroll
    for (int k = 0; k < 4; ++k) { const int d = 8 * (wq + 4 * k) + (lane >> 3);
        const bf16_t* src = dir == 0 ? p.GK + (pr0 + (size_t)(d >> 1)) * 512 + h * 128 + (d & 1) * 64 + (lane & 7) * 8
                                     : p.KDB + (((size_t)bh * NCH + ci) * 128 + d) * 64 + (lane & 7) * 8;
        st.k[k] = *(const u32x4*)src; }
    if (wq < 2) { const int row = 32 * wq + (lane >> 1); st.v = *(const u32x4*)(p.GV + (pr0 + row) * 1024 + h * 256 + 16 * dvb + (lane & 1) * 8); }
    { const int fq = lane >> 4; const float* gp = p.GAM + (((size_t)dir * 16 + bh) * NCH + ci) * 128 + 32 * wq + 4 * fq; st.g0 = *(const f32x4*)gp; st.g1 = *(const f32x4*)(gp + 16); }
}
template <int dir> __device__ __forceinline__ void g2_store(const G2Stage& st, int s, lptr opb, int wq, int lane) {
    const int ci = dir == 0 ? s : (s < 4 ? 3 - s : 71 - s);
    if (ci >= 4) {
#pragma unroll
        for (int k = 0; k < 4; ++k) { const int row = 4 * (wq + 4 * k) + (lane >> 4);
            *(__attribute__((address_space(3))) u32x4*)(opb + G2_QE + row * 256 + (((lane & 15) ^ (row & 15)) << 4)) = st.q[k]; } }
#pragma unroll
    for (int k = 0; k < 4; ++k) { const int d = 8 * (wq + 4 * k) + (lane >> 3);
        *(__attribute__((address_space(3))) u32x4*)(opb + G2_KD + d * 128 + (((lane & 7) ^ ((d >> 1) & 7)) << 4)) = st.k[k]; }
    if (wq < 2) *(__attribute__((address_space(3))) u32x4*)(opb + G2_V + wq * 1024 + lane * 16) = st.v;
}
template <int dir> __device__ __forceinline__ void g2_step(const Ptrs& p, int s, G2Stage& R1, G2Stage& R2, f32x4& S0, f32x4& S1, f32x4& g0, f32x4& g1, lptr lds, int wq, int bh, int dvb, int lane) {
    const int fr = lane & 15, fq = lane >> 4, b = bh >> 2, h = bh & 3;
    const int buf = s & 1;
    const int ci = dir == 0 ? s : (s < 4 ? 3 - s : 71 - s);
    const bool isx = ci >= 4; const size_t m0 = (size_t)b * T + (size_t)(ci - 4) * 64;
    const lptr opb = lds + (buf * 2 + dir) * G2_OPB;
    __attribute__((address_space(3))) bf16_t* st = (__attribute__((address_space(3))) bf16_t*)(lds + G2_ST) + (buf * 2 + dir) * 16 * G2_STP;
    if (isx) {
        *(__attribute__((address_space(3))) u32x2*)(st + fr * G2_STP + 32 * wq + 4 * fq) = (u32x2){cvtpk(S0[0], S0[1]), cvtpk(S0[2], S0[3])};
        *(__attribute__((address_space(3))) u32x2*)(st + fr * G2_STP + 32 * wq + 16 + 4 * fq) = (u32x2){cvtpk(S1[0], S1[1]), cvtpk(S1[2], S1[3])};
    }
    asm volatile("s_waitcnt lgkmcnt(0)" ::: "memory");
    __builtin_amdgcn_s_barrier();
    asm volatile("" ::: "memory");
    if (s + 2 < NCH) g2_load<dir>(p, R2, s + 2, wq, bh, dvb, lane);
    if (isx) {
        f32x4 acc = {0.f, 0.f, 0.f, 0.f};
#pragma unroll
        for (int u = 0; u < 4; ++u) {
            const bf16x8 sf = *(const __attribute__((address_space(3))) bf16x8*)(st + fr * G2_STP + 32 * u + 8 * fq);
            const bf16x8 qf = *(const __attribute__((address_space(3))) bf16x8*)(opb + G2_QE + (16 * wq + fr) * 256 + (((4 * u + fq) ^ fr) << 4));
            acc = __builtin_amdgcn_mfma_f32_16x16x32_bf16(qf, sf, acc, 0, 0, 0);
        }
        bf16_t* op = (dir == 0 ? p.OI : p.OIB) + (m0 + 16 * wq + 4 * fq) * 1024 + h * 256 + 16 * dvb + fr;
#pragma unroll
        for (int r = 0; r < 4; ++r) op[(size_t)r * 1024] = (bf16_t)f2bf(acc[r]);
    }
    bf16x8 vB[2];
#pragma unroll
    for (int ks = 0; ks < 2; ++ks) {
        const lds_cptr a0 = (lds_cptr)(opb + G2_V) + (32 * ks + 8 * fq + (fr >> 2)) * 32 + (fr & 3) * 8;
        const s16x4 l = vtr(a0), hh = vtr(a0 + 4 * 32);
        vB[ks] = (bf16x8){l[0], l[1], l[2], l[3], hh[0], hh[1], hh[2], hh[3]};
    }
    { const int d = 32 * wq + fr; const lptr kr = opb + G2_KD + d * 128;
      const bf16x8 a0 = *(const __attribute__((address_space(3))) bf16x8*)(kr + (((0 + fq) ^ ((d >> 1) & 7)) << 4)), a1 = *(const __attribute__((address_space(3))) bf16x8*)(kr + (((4 + fq) ^ ((d >> 1) & 7)) << 4));
      S0 = S0 * g0; S0 = __builtin_amdgcn_mfma_f32_16x16x32_bf16(a0, vB[0], S0, 0, 0, 0); S0 = __builtin_amdgcn_mfma_f32_16x16x32_bf16(a1, vB[1], S0, 0, 0, 0); }
    { const int d = 32 * wq + 16 + fr; const lptr kr = opb + G2_KD + d * 128;
      const bf16x8 a0 = *(const __attribute__((address_space(3))) bf16x8*)(kr + (((0 + fq) ^ ((d >> 1) & 7)) << 4)), a1 = *(const __attribute__((address_space(3))) bf16x8*)(kr + (((4 + fq) ^ ((d >> 1) & 7)) << 4));
      S1 = S1 * g1; S1 = __builtin_amdgcn_mfma_f32_16x16x32_bf16(a0, vB[0], S1, 0, 0, 0); S1 = __builtin_amdgcn_mfma_f32_16x16x32_bf16(a1, vB[1], S1, 0, 0, 0); }
    if (s + 1 < NCH) { g2_store<dir>(R1, s + 1, lds + ((buf ^ 1) * 2 + dir) * G2_OPB, wq, lane);
        g0 = R1.g0; g1 = R1.g1; }
}
template <int dir> __device__ __forceinline__ void g2_dir(const Ptrs& p, int pair, lptr lds, int tid) {
    const int wave = __builtin_amdgcn_readfirstlane(tid >> 6), lane = tid & 63, wq = wave & 3;
    const int bh = pair >> 4, dvb = pair & 15;
    f32x4 S0 = {0.f, 0.f, 0.f, 0.f}, S1 = {0.f, 0.f, 0.f, 0.f};
    G2Stage X, Y;
    g2_load<dir>(p, X, 0, wq, bh, dvb, lane); g2_store<dir>(X, 0, lds + (0 * 2 + dir) * G2_OPB, wq, lane);
    f32x4 g0 = X.g0, g1 = X.g1;
    g2_load<dir>(p, X, 1, wq, bh, dvb, lane);
    static_assert(NCH % 2 == 0, "two steps per trip");
    for (int s = 0; s < NCH; s += 2) {
        g2_step<dir>(p, s, X, Y, S0, S1, g0, g1, lds, wq, bh, dvb, lane);
        g2_step<dir>(p, s + 1, Y, X, S0, S1, g0, g1, lds, wq, bh, dvb, lane);
    }
    asm volatile("s_waitcnt vmcnt(0) lgkmcnt(0)" ::: "memory");
    __builtin_amdgcn_s_barrier();
}
__device__ __forceinline__ void g2_wg(const Ptrs& p, int pair, lptr lds, int tid) {
    if (__builtin_amdgcn_readfirstlane(tid >> 8) == 0) g2_dir<0>(p, pair, lds, tid); else g2_dir<1>(p, pair, lds, tid);
}

constexpr int G3_SS = 32768;
__device__ __forceinline__ void g3_unit(const Ptrs& p, int bh, int c, lptr lds, int tid) {
    const int b = bh >> 2, h = bh & 3, wave = tid >> 6, lane = tid & 63, r32 = lane & 31, hi = lane >> 5;
    const size_t pr0 = (size_t)b * P + (size_t)(c + 4) * 64, m0 = (size_t)b * T + (size_t)c * 64;
    { const int sr = tid >> 4, sc = (tid & 15) * 8;
#pragma unroll
      for (int tile = 0; tile < 2; ++tile)
#pragma unroll
          for (int rr = 0; rr < 2; ++rr) { const int row = sr + 32 * rr;
              const bf16x8 x = *(const bf16x8*)(p.GV + (pr0 + row) * 1024 + h * 256 + tile * 128 + sc);
              *(__attribute__((address_space(3))) bf16x8*)(lds + tile * 16384 + att::v_st(row, sc)) = x; } }
    const int tt = wave & 1, dq = wave >> 1, t = 32 * tt + r32;
    const bf16_t* ap = p.AM + (((size_t)bh * 64 + c) * 64 + t) * 64 + 8 * hi;
    bf16x8 bfr[4];
#pragma unroll
    for (int ks = 0; ks < 4; ++ks) bfr[ks] = *(const bf16x8*)(ap + 16 * ks);
    __syncthreads();
    f32x16 od[2];
#pragma unroll
    for (int k2 = 0; k2 < 2; ++k2) {
#pragma unroll
        for (int r = 0; r < 16; ++r) od[k2][r] = 0.f;
        const int dvt = 2 * dq + k2, tile = dvt >> 2, d0 = dvt & 3;
        const lds_cptr vb = (lds_cptr)lds + tile * 16384 + att::v_rd_base(lane) + d0 * 512;
#pragma unroll
        for (int ks = 0; ks < 4; ++ks) {
            const s16x4 l = vtr(vb + ks * 4096), hh = vtr(vb + ks * 4096 + 2048);
            const bf16x8 va = (bf16x8){l[0], l[1], l[2], l[3], hh[0], hh[1], hh[2], hh[3]};
            od[k2] = __builtin_amdgcn_mfma_f32_32x32x16_bf16(va, bfr[ks], od[k2], 0, 0, 0);
        }
    }
    const size_t rowp = (m0 + t) * 1024 + h * 256;
    float ss = 0.f;
#pragma unroll
    for (int k2 = 0; k2 < 2; ++k2)
#pragma unroll
        for (int g4 = 0; g4 < 4; ++g4) { const int dv0 = 64 * dq + 32 * k2 + 8 * g4 + 4 * hi;
            const u32x2 w = *(const u32x2*)(p.OI + rowp + dv0), w2 = *(const u32x2*)(p.OIB + rowp + dv0);
            od[k2][4 * g4 + 0] += bflo(w.x) + bflo(w2.x); od[k2][4 * g4 + 1] += bfhi(w.x) + bfhi(w2.x); od[k2][4 * g4 + 2] += bflo(w.y) + bflo(w2.y); od[k2][4 * g4 + 3] += bfhi(w.y) + bfhi(w2.y);
#pragma unroll
            for (int e = 0; e < 4; ++e) ss += od[k2][4 * g4 + e] * od[k2][4 * g4 + e]; }
    ss += __shfl_xor(ss, 32);
    __attribute__((address_space(3))) float* SS = (__attribute__((address_space(3))) float*)(lds + G3_SS);
    if (hi == 0) SS[t * 4 + dq] = ss;
    __syncthreads();
    const float tot = (SS[t * 4 + 0] + SS[t * 4 + 1]) + (SS[t * 4 + 2] + SS[t * 4 + 3]);
    const float rstd = __builtin_amdgcn_rsqf(tot * (1.f / 256.f) + EPS);
#pragma unroll
    for (int k2 = 0; k2 < 2; ++k2)
#pragma unroll
        for (int g4 = 0; g4 < 4; ++g4) { const int dv0 = 64 * dq + 32 * k2 + 8 * g4 + 4 * hi;
            const u32x2 gw = *(const u32x2*)(p.GO + rowp + dv0); const f32x4 gn = *(const f32x4*)(p.gla_norm + dv0);
            const float g0 = bflo(gw.x), g1 = bfhi(gw.x), g2 = bflo(gw.y), g3 = bfhi(gw.y);
            const float y0 = od[k2][4 * g4 + 0] * rstd * gn[0] * (g0 * sigmoidf_(g0)), y1 = od[k2][4 * g4 + 1] * rstd * gn[1] * (g1 * sigmoidf_(g1));
            const float y2 = od[k2][4 * g4 + 2] * rstd * gn[2] * (g2 * sigmoidf_(g2)), y3 = od[k2][4 * g4 + 3] * rstd * gn[3] * (g3 * sigmoidf_(g3));
            *(u32x2*)(p.GO + rowp + dv0) = (u32x2){cvtpk(y0, y1), cvtpk(y2, y3)}; }
    __syncthreads();
}
}

namespace pro {
typedef __attribute__((address_space(3))) unsigned char* lptr;
typedef __attribute__((address_space(3))) float* lfp;
__device__ __forceinline__ unsigned pk2f(float lo, float hi) { return f2bf(lo) | (f2bf(hi) << 16); }

__device__ __forceinline__ void ada_item(int jb, const float* __restrict__ c, const float* __restrict__ c_ctx, const float* __restrict__ w_ada, const float* __restrict__ b_ada,
                                         float* __restrict__ MODX, float* __restrict__ MODC, lptr lds, int tid) {
    lfp SC = (lfp)lds; lfp RED = (lfp)(lds + 20480);
    for (int e = tid; e < 5120; e += 512) { const int r = e >> 10, k = e & 1023; const float x = r < 4 ? c[r * 1024 + k] : c_ctx[k]; SC[e] = x / (1.f + __expf(-x)); }
    __syncthreads();
    const int c4 = tid & 7, kk = tid >> 3;
    f32x4 acc[5];
#pragma unroll
    for (int r = 0; r < 5; ++r) acc[r] = (f32x4){0.f, 0.f, 0.f, 0.f};
#pragma unroll 4
    for (int i = 0; i < 16; ++i) { const int k = kk + 64 * i; const f32x4 w = *(const f32x4*)(w_ada + (size_t)k * 6144 + jb * 32 + c4 * 4);
#pragma unroll
        for (int r = 0; r < 5; ++r) acc[r] += w * SC[r * 1024 + k]; }
#pragma unroll
    for (int r = 0; r < 5; ++r) *(__attribute__((address_space(3))) f32x4*)(RED + (kk * 5 + r) * 32 + c4 * 4) = acc[r];
    __syncthreads();
    if (tid < 160) { const int r = tid >> 5, jl = tid & 31, j = jb * 32 + jl; float s = 0.f;
        for (int q = 0; q < 64; ++q) s += RED[(q * 5 + r) * 32 + jl];
        s += b_ada[j];
        if (r < 4) MODX[r * 6144 + j] = s; else if (j < 2048) MODC[j] = s; }
    __syncthreads();
}
__device__ __forceinline__ void conv_item(const float* __restrict__ W, int K, int N, int src_n0, bf16_t* __restrict__ WT, int dst_n0, int k0, lfp scr, int lane) {
#pragma unroll 8
    for (int i = 0; i < 32; ++i) { const int kk = 2 * i + (lane >> 5); scr[kk * 33 + (lane & 31)] = src_n0 >= 0 ? W[(size_t)(k0 + kk) * N + src_n0 + (lane & 31)] : 0.f; }
    asm volatile("s_waitcnt lgkmcnt(0)" ::: "memory");
    const int c = lane & 7;
#pragma unroll
    for (int j = 0; j < 4; ++j) { const int n = (lane >> 3) + 8 * j; const lfp s = scr + (8 * c) * 33 + n;
        u32x4 o; o.x = pk2f(s[0 * 33], s[1 * 33]); o.y = pk2f(s[2 * 33], s[3 * 33]); o.z = pk2f(s[4 * 33], s[5 * 33]); o.w = pk2f(s[6 * 33], s[7 * 33]);
        *(u32x4*)(WT + (size_t)(dst_n0 + n) * K + k0 + 8 * c) = o; }
    asm volatile("s_waitcnt lgkmcnt(0)" ::: "memory");
}
struct Weights { const float *w_in, *wa, *wg, *wo, *w1, *w2; bf16_t *WinT, *WaT, *WgT, *WoT, *W1T, *W2T; };
constexpr int I_IN = 16 * 210, I_SQ = 16 * 32, I_W1 = 16 * 128, I_W2 = 64 * 32, I_ALL = I_IN + 3 * I_SQ + I_W1 + I_W2;
__device__ __forceinline__ void conv_any(const Weights& w, int it, lfp scr, int lane) {
    if (it < I_IN) { const int kb = it / 210, nb = it % 210; conv_item(w.w_in, 1024, 6688, win_src_col(32 * nb), w.WinT, 32 * nb, 64 * kb, scr, lane); return; } it -= I_IN;
    if (it < I_SQ) { conv_item(w.wa, 1024, 1024, 32 * (it & 31), w.WaT, 32 * (it & 31), 64 * (it >> 5), scr, lane); return; } it -= I_SQ;
    if (it < I_SQ) { conv_item(w.wg, 1024, 1024, 32 * (it & 31), w.WgT, 32 * (it & 31), 64 * (it >> 5), scr, lane); return; } it -= I_SQ;
    if (it < I_SQ) { conv_item(w.wo, 1024, 1024, 32 * (it & 31), w.WoT, 32 * (it & 31), 64 * (it >> 5), scr, lane); return; } it -= I_SQ;
    if (it < I_W1) { conv_item(w.w1, 1024, 4096, 32 * (it & 127), w.W1T, 32 * (it & 127), 64 * (it >> 7), scr, lane); return; } it -= I_W1;
    conv_item(w.w2, 4096, 1024, 32 * (it & 31), w.W2T, 32 * (it & 31), 64 * (it >> 5), scr, lane);
}
__device__ __forceinline__ void norm_mod_row(const float* __restrict__ xr, const float* __restrict__ gw, const float* __restrict__ sh, const float* __restrict__ sc, bf16_t* __restrict__ orow, int lane) {
    f32x4 v[4]; float s = 0.f;
#pragma unroll
    for (int j = 0; j < 4; ++j) { v[j] = *(const f32x4*)(xr + 4 * lane + 256 * j); s += (v[j][0] * v[j][0] + v[j][1] * v[j][1]) + (v[j][2] * v[j][2] + v[j][3] * v[j][3]); }
    const float r = __builtin_amdgcn_rsqf(wave_sum(s) * (1.f / 1024.f) + EPS);
#pragma unroll
    for (int j = 0; j < 4; ++j) { const int k = 4 * lane + 256 * j; const f32x4 g = *(const f32x4*)(gw + k), a = *(const f32x4*)(sc + k), b = *(const f32x4*)(sh + k);
        const f32x4 y = (v[j] * r * g) * (a + 1.f) + b;
        *(u32x2*)(orow + k) = (u32x2){pk2f(y[0], y[1]), pk2f(y[2], y[3])}; }
}
__device__ __forceinline__ void qkrope_chunk(bf16_t* __restrict__ chunk, const float* __restrict__ gw, const float* __restrict__ rope, int pos, bool dorope, int lane) {
    const int sub = lane & 7;
    bf16_t* p = chunk + (lane >> 3) * 128 + sub * 16;
    const u32x4 w0 = *(const u32x4*)p, w1 = *(const u32x4*)(p + 8);
    float v[16];
    v[0] = bflo(w0.x); v[1] = bfhi(w0.x); v[2] = bflo(w0.y); v[3] = bfhi(w0.y); v[4] = bflo(w0.z); v[5] = bfhi(w0.z); v[6] = bflo(w0.w); v[7] = bfhi(w0.w);
    v[8] = bflo(w1.x); v[9] = bfhi(w1.x); v[10] = bflo(w1.y); v[11] = bfhi(w1.y); v[12] = bflo(w1.z); v[13] = bfhi(w1.z); v[14] = bflo(w1.w); v[15] = bfhi(w1.w);
    float s = 0.f;
#pragma unroll
    for (int i = 0; i < 16; ++i) s += v[i] * v[i];
    s += __shfl_xor(s, 1); s += __shfl_xor(s, 2); s += __shfl_xor(s, 4);
    const float r = __builtin_amdgcn_rsqf(s * (1.f / 128.f) + EPS);
#pragma unroll
    for (int i = 0; i < 16; i += 4) { const f32x4 g = *(const f32x4*)(gw + sub * 16 + i); v[i] *= r * g[0]; v[i + 1] *= r * g[1]; v[i + 2] *= r * g[2]; v[i + 3] *= r * g[3]; }
    if (dorope) {
        const int axis = sub >> 2, half = (sub >> 1) & 1, f0 = (sub & 1) * 16;
        const int ap = axis == 0 ? (pos >> 6) : (pos & 63);
        const float* rp = rope + (size_t)(ap * 32 + f0) * 2;
#pragma unroll
        for (int i = 0; i < 16; i += 2) { const f32x4 cs = *(const f32x4*)(rp + 2 * i);
            const float q0 = __shfl_xor(v[i], 2), q1 = __shfl_xor(v[i + 1], 2);
            v[i] = half == 0 ? v[i] * cs[0] - q0 * cs[1] : v[i] * cs[0] + q0 * cs[1];
            v[i + 1] = half == 0 ? v[i + 1] * cs[2] - q1 * cs[3] : v[i + 1] * cs[2] + q1 * cs[3]; }
    }
    *(u32x4*)p = (u32x4){pk2f(v[0], v[1]), pk2f(v[2], v[3]), pk2f(v[4], v[5]), pk2f(v[6], v[7])};
    *(u32x4*)(p + 8) = (u32x4){pk2f(v[8], v[9]), pk2f(v[10], v[11]), pk2f(v[12], v[13]), pk2f(v[14], v[15])};
}
}


constexpr int RING_OFF = 0, RING_BYTES = 131072;
constexpr int LDSCTL_OFF = 163328, MISC_OFF = LDSCTL_OFF + 320;
constexpr int LDS_BYTES = 163840;
constexpr int NWAVES = 8;
constexpr int CW_BAR = 4096;

enum Phase { PH_PRO = 0, PH_NORM1, PH_INPROJ, PH_QKROPE, PH_ATTN, PH_MERGEA, PH_G1, PH_G2, PH_G3, PH_MERGEB, PH_OUT, PH_NORM2, PH_MLP1, PH_MLP2, PH_END };

struct Args { const float* in[21]; float* out; unsigned char* ws; int ph_lo, ph_hi; };

__device__ __forceinline__ void lr_unit(const bf16_t* __restrict__ XNall, const bf16_t* __restrict__ WlrT, float* __restrict__ LR, int u, int wave, int lane) {
    const int r32 = lane & 31, hi = lane >> 5;
    const bf16_t* ap = XNall + (size_t)(u * 256 + wave * 32 + r32) * 1024 + hi * 8;
    const bf16_t* bp = WlrT + (size_t)r32 * 1024 + hi * 8;
    f32x16 acc;
#pragma unroll
    for (int r = 0; r < 16; ++r) acc[r] = 0.f;
#pragma unroll 8
    for (int k0 = 0; k0 < 1024; k0 += 16) {
        const bf16x8 a = *(const bf16x8*)(ap + k0), b = *(const bf16x8*)(bp + k0);
        acc = __builtin_amdgcn_mfma_f32_32x32x16_bf16(a, b, acc, 0, 0, 0);
    }
#pragma unroll
    for (int r = 0; r < 16; ++r) { const int m = u * 256 + wave * 32 + crow(r, hi); LR[prow(m) * 32 + r32] = acc[r]; }
}

__global__ void __launch_bounds__(NWAVES * 64, 2) mk_fwd(Args args) {
    extern __shared__ __attribute__((aligned(16))) unsigned char lds[];
    LAS unsigned char* ldsl = (LAS unsigned char*)lds;
    volatile LAS unsigned* MISC = (volatile LAS unsigned*)(ldsl + MISC_OFF);
    const int tid = threadIdx.x, lane = tid & 63, wave = __builtin_amdgcn_readfirstlane(tid >> 6);
    const int G = gridDim.x, bx = blockIdx.x;
    unsigned char* ws = args.ws;
    gu32* ctl = (gu32*)(ws + WS_CTL);
#define PHASE_BASES unsigned char* wsp = ws; unsigned char* dop = (unsigned char*)args.out
#define WP(T, off) ((T*)(wsp + (off)))
#define MODX WP(float, WS_MODX)
#define WinT WP(bf16_t, WS_WIN)
#define WaT WP(bf16_t, WS_WA)
#define WgT WP(bf16_t, WS_WG)
#define WoT WP(bf16_t, WS_WO)
#define W1T WP(bf16_t, WS_W1)
#define W2T WP(bf16_t, WS_W2)
#define KA WP(bf16_t, WS_KA)
#define VA WP(bf16_t, WS_VA)
#define GK WP(bf16_t, WS_GK)
#define GV WP(bf16_t, WS_GV)
#define LR WP(float, WS_LR)
#define QA WP(bf16_t, WS_QA)
#define GQ WP(bf16_t, WS_GQ)
#define GO WP(bf16_t, WS_GO)
#define GA WP(bf16_t, WS_GA)
#define GG WP(bf16_t, WS_GG)
#define Y WP(bf16_t, WS_Y)
#define HN WP(bf16_t, WS_HN)
#define H WP(bf16_t, WS_H)
#define XN ((bf16_t*)dop)
#define OUTP ((float*)dop)
#define GLA_PTRS gla::Ptrs gp{GK, GV, GQ, WP(bf16_t, WS_QEB), (bf16_t*)(dop + DO_KDB), WP(float, WS_GAM), (bf16_t*)(dop + DO_AM), (bf16_t*)(dop + DO_OI), WP(bf16_t, WS_OIB), GO, LR, args.in[10], args.in[11], args.in[12], args.in[13], args.in[14]}
    for (int u = tid; u < (LDS_BYTES - LDSCTL_OFF) / 4; u += NWAVES * 64) ((LAS unsigned*)(ldsl + LDSCTL_OFF))[u] = 0u;
    __syncthreads();
    const int lo = args.ph_lo, hi = args.ph_hi;
    const bool multi = (hi - lo) > 1;
    XcdBarrier bar; bar.bar = (unsigned*)(ctl + CW_BAR); bar.x = 0; bar.st = nullptr;
    if (multi) bar = xcd_barrier_post((unsigned*)(ctl + CW_BAR), MISC + 8);
#define IN(k) (lo <= (k) && (k) < hi)
#ifdef MK_DIAG
#define STAMP(k) do { if (bx == 0 && tid == 0) ((unsigned long long*)(ws + WS_CTL + 8192))[(k)] = __builtin_amdgcn_s_memrealtime(); } while (0)
#else
#define STAMP(k) do {} while (0)
#endif
#define SEAM(k) do { if (IN(k) && IN((k) + 1)) xcd_barrier(bar); STAMP((k) + 1); } while (0)
    STAMP(0);

    if (IN(PH_PRO)) { PHASE_BASES;
        for (int jb = bx; jb < 192; jb += G) pro::ada_item(jb, args.in[1], args.in[3], args.in[4], args.in[5], MODX, WP(float, WS_MODC), ldsl + RING_OFF, tid);
        if (bx == G - 1) { float* rope = WP(float, WS_ROPE);
            for (int i = tid; i < 64 * 32; i += NWAVES * 64) { const int pos = i >> 5, f = i & 31; const float ang = (float)pos * powf(10000.f, -(float)(2 * f) / 64.f); rope[2 * i] = cosf(ang); rope[2 * i + 1] = sinf(ang); } }
        const pro::Weights W{args.in[7], args.in[15], args.in[16], args.in[17], args.in[19], args.in[20], WinT, WaT, WgT, WoT, W1T, W2T};
        for (int it = bx * NWAVES + wave; it < pro::I_ALL; it += G * NWAVES) pro::conv_any(W, it, (pro::lfp)(ldsl + RING_OFF + wave * 16384), lane);
    }
    SEAM(PH_PRO);
    if (IN(PH_NORM1)) { PHASE_BASES;
        const float* MODC = WP(const float, WS_MODC);
        for (int row = bx * NWAVES + wave; row < MALL; row += G * NWAVES) {
            if (row < M) { const float* sh = MODX + (size_t)(row >> 12) * 6144; pro::norm_mod_row(args.in[0] + (size_t)row * DM, args.in[6], sh, sh + DM, XN + (size_t)row * DM, lane); }
            else pro::norm_mod_row(args.in[2] + (size_t)(row - M) * DM, args.in[6], MODC, MODC + DM, XN + (size_t)row * DM, lane);
        }
    }
    SEAM(PH_NORM1);
    if (IN(PH_INPROJ)) { PHASE_BASES;
        pg8::Gemm g{XN, WinT, MALL, NIN, DM}; pg8::InOrder S; S.init(G, bx);
        pg8::EpiInProj E{KA, VA, GK, GV, QA, GQ, GO, GA, GG};
        pg8::gemm_phase<pg8::EpiInProj, pg8::InOrder, true, true>(ldsl + RING_OFF, g, S, E);
        if (bx >= 160 && bx < 160 + 68) lr_unit(XN, WinT + (size_t)NIN * DM, LR, bx - 160, wave, lane);
    }
    SEAM(PH_INPROJ);
    if (IN(PH_QKROPE)) { PHASE_BASES;
        const float* rope = WP(const float, WS_ROPE);
        for (int ch = bx * NWAVES + wave; ch < M + NB * P / 4; ch += G * NWAVES) {
            if (ch < M) pro::qkrope_chunk(QA + (size_t)ch * 1024, args.in[8], rope, ch & 4095, true, lane);
            else { const int ki = ch - M, row = 4 * ki + (lane >> 4), pp = row % P;
                   pro::qkrope_chunk(KA + (size_t)ki * 1024, args.in[9], rope, pp - CTX, ((4 * ki) % P) >= CTX, lane); }
        }
    }
    SEAM(PH_QKROPE);
    if (IN(PH_ATTN)) { PHASE_BASES;
        for (int L = bx; L < 512; L += G) { const int xg = L & 7, u = L >> 3, b = xg >> 1, kvh = xg & 1, h = kvh * 4 + (u >> 4), qb = u & 15;
            bf16_t* Qb = QA + ((size_t)(b * T + qb * 256)) * 1024 + h * 128;
            att::attn_dense_body<att::bf16>(Qb, KA + (size_t)b * P * 256 + kvh * 128, VA + (size_t)b * P * 256 + kvh * 128, Qb, P, (char*)lds + RING_OFF); }
    }
    SEAM(PH_ATTN);
    if (IN(PH_MERGEA)) { PHASE_BASES;
        pg8::Gemm g{QA, WaT, M, DM, DM}; pg8::StaticOrder S; S.init(M, DM, G, bx); pg8::EpiMerge<true> E{Y, Y};
        pg8::gemm_phase<pg8::EpiMerge<true>, pg8::StaticOrder, false, true>(ldsl + RING_OFF, g, S, E);
    }
    SEAM(PH_MERGEA);
    if (IN(PH_G1)) { PHASE_BASES; GLA_PTRS; for (int L = bx; L < 16 * NCH; L += G) gla::g1_unit(gp, L & 15, L >> 4, ldsl + RING_OFF, tid); }
    SEAM(PH_G1);
    if (IN(PH_G2)) { PHASE_BASES; GLA_PTRS;
        for (int L = bx; L < 256; L += G) { const int j = L >> 3; gla::g2_wg(gp, (((L & 7) * 2 + (j >> 4)) << 4) | (j & 15), ldsl + RING_OFF, tid); } }
    SEAM(PH_G2);
    if (IN(PH_G3)) { PHASE_BASES; GLA_PTRS; for (int L = bx; L < 1024; L += G) gla::g3_unit(gp, L & 15, L >> 4, ldsl + RING_OFF, tid); }
    SEAM(PH_G3);
    if (IN(PH_MERGEB)) { PHASE_BASES;
        pg8::Gemm g{GO, WgT, M, DM, DM}; pg8::StaticOrder S; S.init(M, DM, G, bx); pg8::EpiMerge<false> E{GG, Y};
        pg8::gemm_phase<pg8::EpiMerge<false>, pg8::StaticOrder, false, true>(ldsl + RING_OFF, g, S, E);
    }
    SEAM(PH_MERGEB);
    if (IN(PH_OUT)) { PHASE_BASES;
        pg8::Gemm g{Y, WoT, M, DM, DM}; pg8::StaticOrder S; S.init(M, DM, G, bx); pg8::EpiGateRes E{args.in[0], OUTP, MODX + 2 * DM};
        pg8::gemm_phase<pg8::EpiGateRes, pg8::StaticOrder, false, true>(ldsl + RING_OFF, g, S, E);
    }
    SEAM(PH_OUT);
    if (IN(PH_NORM2)) { PHASE_BASES;
        for (int row = bx * NWAVES + wave; row < M; row += G * NWAVES) { const float* sh = MODX + (size_t)(row >> 12) * 6144 + 3 * DM;
            pro::norm_mod_row(OUTP + (size_t)row * DM, args.in[18], sh, sh + DM, HN + (size_t)row * DM, lane); }
    }
    SEAM(PH_NORM2);
    if (IN(PH_MLP1)) { PHASE_BASES;
        pg8::Gemm g{HN, W1T, M, FF, DM}; pg8::StaticOrder S; S.init(M, FF, G, bx); pg8::EpiSqRelu E{H};
        pg8::gemm_phase<pg8::EpiSqRelu, pg8::StaticOrder, true, true>(ldsl + RING_OFF, g, S, E);
    }
    SEAM(PH_MLP1);
    if (IN(PH_MLP2)) { PHASE_BASES;
        pg8::Gemm g{H, W2T, M, DM, FF}; pg8::StaticOrder S; S.init(M, DM, G, bx); pg8::EpiGateRes E{OUTP, OUTP, MODX + 5 * DM};
        pg8::gemm_phase<pg8::EpiGateRes, pg8::StaticOrder, false, true>(ldsl + RING_OFF, g, S, E);
    }
#ifdef MK_DIAG
    {
        asm volatile("s_waitcnt vmcnt(0)" ::: "memory"); __syncthreads();
        xcd_barrier(bar);
        STAMP(PH_END);
        asm volatile("s_waitcnt vmcnt(0)" ::: "memory"); __syncthreads();
        const unsigned long long* ts = (const unsigned long long*)(ws + WS_CTL + 8192);
        const float dA = (float)(__hip_atomic_load(ts + MK_DIAG_A + 1, __ATOMIC_RELAXED, __HIP_MEMORY_SCOPE_AGENT) - __hip_atomic_load(ts + MK_DIAG_A, __ATOMIC_RELAXED, __HIP_MEMORY_SCOPE_AGENT)) * 0.01f;
        const float dB = MK_DIAG_B >= 0 ? (float)(__hip_atomic_load(ts + MK_DIAG_B + 1, __ATOMIC_RELAXED, __HIP_MEMORY_SCOPE_AGENT) - __hip_atomic_load(ts + MK_DIAG_B, __ATOMIC_RELAXED, __HIP_MEMORY_SCOPE_AGENT)) * 0.01f : 100.f;
        pg8::StaticOrder S; S.init(M, DM, G, bx); pg8::Unit u; S.next(0, u);
        float* out = args.out; for (int e = tid; e < 65536; e += NWAVES * 64) out[(size_t)(u.pm * 256 + (e >> 8)) * 1024 + u.pn * 256 + (e & 255)] += dB * MK_DIAG_SB;
        asm volatile("s_waitcnt vmcnt(0)" ::: "memory"); __syncthreads();
        if (bx == 0 && tid == 0) out[0] += dA * 0.01f;
    }
#endif
#undef IN
#undef SEAM
}

extern "C" void kernel_launch(void* const* d_in, const int* in_sizes, int n_in, void* d_out, int out_size, void* d_ws, size_t ws_size, hipStream_t stream) {
    (void)in_sizes; (void)n_in; (void)out_size; (void)ws_size;
    static int grid = 0;
    if (grid == 0) {
        int dev = 0, cus = 0, per_cu = 0;
        if (hipGetDevice(&dev) != hipSuccess || hipDeviceGetAttribute(&cus, hipDeviceAttributeMultiprocessorCount, dev) != hipSuccess) { fprintf(stderr, "kernel_launch: device query failed\n"); grid = -1; return; }
        if (hipFuncSetAttribute((const void*)mk_fwd, hipFuncAttributeMaxDynamicSharedMemorySize, LDS_BYTES) != hipSuccess) { fprintf(stderr, "kernel_launch: hipFuncSetAttribute failed\n"); grid = -1; return; }
        if (hipOccupancyMaxActiveBlocksPerMultiprocessor(&per_cu, (const void*)mk_fwd, NWAVES * 64, LDS_BYTES) != hipSuccess || per_cu < 1) { fprintf(stderr, "kernel_launch: occupancy query says %d blocks/CU\n", per_cu); per_cu = 1; }
        (void)hipGetLastError();
        grid = cus;
        if (grid != 256) fprintf(stderr, "kernel_launch: %d CUs (built for 256)\n", grid);
    }
    if (grid < 0) return;
    unsigned char* ws = (unsigned char*)d_ws; float* out = (float*)d_out;
    (void)hipMemsetAsync(ws + WS_CTL, 0, CTL_ZERO_BYTES, stream);
    Args a{}; for (int i = 0; i < 21; ++i) a.in[i] = (const float*)d_in[i]; a.out = out; a.ws = ws;
#ifndef MK_PER_PHASE
    a.ph_lo = 0; a.ph_hi = PH_END; hipLaunchKernelGGL(mk_fwd, dim3(grid), dim3(NWAVES * 64), LDS_BYTES, stream, a);
#else
    for (int p = 0; p < PH_END; ++p) { a.ph_lo = p; a.ph_hi = p + 1; hipLaunchKernelGGL(mk_fwd, dim3(grid), dim3(NWAVES * 64), LDS_BYTES, stream, a); }
#endif
    const hipError_t le = hipPeekAtLastError();
    if (le != hipSuccess) fprintf(stderr, "kernel_launch: launch failed: %s\n", hipGetErrorName(le));
}
```

```cpp
#include <hip/hip_runtime.h>
#include <cstdio>
#include <cstdint>

constexpr int NB = 4, T = 4096, DM = 1024, CTX = 256, P = CTX + T  ;
constexpr int M = NB * T, MC = NB * CTX, MALL = M + MC;
constexpr int NIN = 6656;
constexpr int FF = 4096;
constexpr int NCH = P / 64;
constexpr float EPS = 1e-6f;
constexpr float QSCALE = 0.08838834764831845f;

constexpr size_t MiB = 1u << 20;
constexpr size_t WS_CTL = 0, CTL_ZERO_BYTES = 1 * MiB;
constexpr size_t WS_MODX = 1 * MiB, WS_MODC = 1 * MiB + 128 * 1024, WS_ROPE = 1 * MiB + 192 * 1024;
constexpr size_t WS_GAM = 2 * MiB;
constexpr size_t WS_WIN = 4 * MiB, WS_WA = 18 * MiB, WS_WG = 20 * MiB, WS_WO = 22 * MiB, WS_W1 = 24 * MiB, WS_W2 = 32 * MiB;
constexpr size_t WS_QEB = 24 * MiB;
constexpr size_t WS_KDB = 40 * MiB;
constexpr size_t WS_AM = 4 * MiB;
constexpr size_t WS_KA = 40 * MiB, WS_VA = WS_KA + (size_t)NB * P * 256 * 2, WS_GK = 57 * MiB, WS_GV = 74 * MiB, WS_LR = 108 * MiB;
constexpr size_t WS_QA = 111 * MiB, WS_GQ = 143 * MiB, WS_GO = 159 * MiB, WS_GA = 191 * MiB, WS_GG = 223 * MiB;
constexpr size_t WS_Y = WS_GA;
constexpr size_t WS_HN = 191 * MiB, WS_H = 40 * MiB;
static_assert(WS_VA + (size_t)NB * P * 256 * 2 <= WS_GK, "map");
constexpr size_t DO_OI = 0, DO_OIB = 32 * MiB;

typedef unsigned short bf16_t;
typedef short bf16x8 __attribute__((ext_vector_type(8)));
typedef float f32x4 __attribute__((ext_vector_type(4)));
typedef float f32x16 __attribute__((ext_vector_type(16)));
typedef unsigned u32x4 __attribute__((ext_vector_type(4)));
typedef unsigned u32x2 __attribute__((ext_vector_type(2)));

__device__ __forceinline__ unsigned f2bf(float f) { unsigned u = __builtin_bit_cast(unsigned, f); return (u + 0x7fffu + ((u >> 16) & 1u)) >> 16; }
__device__ __forceinline__ float bf2f(bf16_t h) { return __builtin_bit_cast(float, (unsigned)h << 16); }
__device__ __forceinline__ float bflo(unsigned w) { return __builtin_bit_cast(float, w << 16); }
__device__ __forceinline__ float bfhi(unsigned w) { return __builtin_bit_cast(float, w & 0xffff0000u); }
__device__ __forceinline__ float wave_sum(float v) {
#pragma unroll
    for (int o = 1; o < 64; o <<= 1) v += __shfl_xor(v, o);
    return v;
}
__device__ __forceinline__ float sigmoidf_(float x) { return __builtin_amdgcn_rcpf(1.f + __builtin_amdgcn_exp2f(-1.4426950408889634f * x)); }
__device__ __forceinline__ size_t prow(int m) {
    if (m < M) { const int b = m >> 12, t = m & 4095; return (size_t)b * P + CTX + t; }
    const int mc = m - M; const int b = mc >> 8, s = mc & 255; return (size_t)b * P + s;
}
__device__ __forceinline__ int crow(int r, int hi) { return (r & 3) + 8 * (r >> 2) + 4 * hi; }
__device__ __forceinline__ int win_src_col(int nd) {
    if (nd < 2048) return nd;
    if (nd < 6656) return nd + 32;
    if (nd < 6688) return 2048 + (nd - 6656);
    return -1;
}
namespace pg8 {
#define PG8_LAS __attribute__((address_space(3)))
typedef unsigned short bf16_t;
typedef short bf16x8 __attribute__((ext_vector_type(8)));
typedef float f32x4 __attribute__((ext_vector_type(4)));
typedef unsigned u32x4 __attribute__((ext_vector_type(4)));
constexpr int BM = 256, BK = 64, HALF = 128, HTB = HALF * BK * 2  , STAGE_BYTES = 8 * HTB, NXCD = 8, WGM = 8;

__host__ __device__ __forceinline__ int lds_byte(int r, int c) { const int st = (r >> 4) * 2 + (c >> 5), rr = r & 15, cc = c & 31, ob = rr * 64 + cc * 2; return st * 1024 + (ob ^ (((ob >> 9) & 1) << 5)); }
__host__ __device__ __forceinline__ void stage_rc(int b, int& R, int& C) { const int st = b / 1024, sb = b % 1024, swz = sb ^ (((sb >> 9) & 1) << 5); R = (st >> 1) * 16 + swz / 64; C = (st & 1) * 32 + (swz % 64) / 2; }
__host__ __device__ __forceinline__ int perm32(int rho) { const int n = rho >> 4, i = rho & 15; return 8 * (i >> 2) + 4 * n + (i & 3); }

struct Unit { int pm, pn; };
struct Gemm { const bf16_t* A; const bf16_t* Bt; int M, N, K; };

struct StaticOrder {
    int nM, nN, nwg, G, c;
    __host__ __device__ void init(int M, int N, int G_, int c_) { nM = M / BM; nN = N / BM; nwg = nM * nN; G = G_; c = c_; }
    __host__ __device__ bool next(int i, Unit& u) const {
        const long L = (long)i * G + c; if (L >= nwg) return false;
        int wgid = (int)L; { const int q = nwg / NXCD, r = nwg % NXCD, xcd = wgid % NXCD, off = wgid / NXCD; wgid = (xcd < r ? xcd * (q + 1) : r * (q + 1) + (xcd - r) * q) + off; }
        const int nig = WGM * nN, gid = wgid / nig, fm = gid * WGM, gsz = (nM - fm) < WGM ? (nM - fm) : WGM;
        u.pm = fm + ((wgid % nig) % gsz); u.pn = (wgid % nig) / gsz; return true;
    }
    __device__ __forceinline__ void a_ready(const Unit&) const {}
    __device__ __forceinline__ void done(const Unit&) const {}
};

typedef float f32x2c_t __attribute__((ext_vector_type(2))); typedef __bf16 bf16x2c_t __attribute__((ext_vector_type(2)));
__device__ __forceinline__ unsigned cvt_pk_bf16(float lo, float hi) { f32x2c_t v = {lo, hi}; bf16x2c_t b = __builtin_convertvector(v, bf16x2c_t); return __builtin_bit_cast(unsigned, b); }
typedef float f32x2 __attribute__((ext_vector_type(2)));

__device__ __forceinline__ float sigm(float x) { return __builtin_amdgcn_rcpf(1.f + __builtin_amdgcn_exp2f(-1.4426950408889634f * x)); }
__device__ __forceinline__ float lo16(unsigned w) { return __builtin_bit_cast(float, w << 16); }
__device__ __forceinline__ float hi16(unsigned w) { return __builtin_bit_cast(float, w & 0xffff0000u); }
struct EpiInProj {
    static constexpr bool PERM = true, AFTER_DRAIN = false;
    bf16_t *KA, *VA, *GK, *GV, *QA, *GQ, *GO, *GA, *GG;
    const float *q_norm, *k_norm, *rope; PG8_LAS float* ssq;
    __device__ __forceinline__ void operator()(const f32x4 (&acc)[2][2][4][2], const Unit& u, int wr, int wc, int fr, int fq) const {
        const int pn = u.pn; bf16_t* base; int ldc, colt; float sc = 1.f;
        size_t rowbase;
        if (u.pm < 64) { rowbase = pn < 8 ? (size_t)(u.pm >> 4) * 4352 + 256 + (size_t)(u.pm & 15) * 256 : (size_t)u.pm * 256; }
        else rowbase = (size_t)(u.pm - 64) * 4352;
        if (pn == 0) { base = KA; ldc = 256; colt = 0; }
        else if (pn == 1) { base = VA; ldc = 256; colt = 0; }
        else if (pn < 4) { base = GK; ldc = 512; colt = (pn - 2) * 256; }
        else if (pn < 8) { base = GV; ldc = 1024; colt = (pn - 4) * 256; }
        else if (pn < 12) { base = QA; ldc = 1024; colt = (pn - 8) * 256; }
        else if (pn < 14) { base = GQ; ldc = 512; colt = (pn - 12) * 256; sc = 0.08838834764831845f; }
        else if (pn < 18) { base = GO; ldc = 1024; colt = (pn - 14) * 256; }
        else if (pn < 22) { base = GA; ldc = 1024; colt = (pn - 18) * 256; }
        else { base = GG; ldc = 1024; colt = (pn - 22) * 256; }
        const int col0 = colt + wc * 32 + 8 * fq;
        const bool qk = pn == 0 || (pn >= 8 && pn < 12);
        if (!qk) {
#pragma unroll
            for (int ai = 0; ai < 2; ++ai)
#pragma unroll
                for (int m = 0; m < 4; ++m) { bf16_t* rowp = base + (rowbase + (size_t)(ai * HALF + wr * 64 + m * 16 + fr)) * ldc + col0;
#pragma unroll
                    for (int bj = 0; bj < 2; ++bj) { const f32x4 v0 = acc[ai][bj][m][0] * sc, v1 = acc[ai][bj][m][1] * sc;
                        u32x4 w; w.x = cvt_pk_bf16(v0[0], v0[1]); w.y = cvt_pk_bf16(v0[2], v0[3]); w.z = cvt_pk_bf16(v1[0], v1[1]); w.w = cvt_pk_bf16(v1[2], v1[3]);
                        *(u32x4*)(rowp + bj * HALF) = w; } }
            return;
        }
        int frq = fr, fqq = fq; asm volatile("" : "+v"(frq), "+v"(fqq));
#pragma unroll
        for (int ai = 0; ai < 2; ++ai)
#pragma unroll
            for (int m = 0; m < 4; ++m)
#pragma unroll
                for (int bj = 0; bj < 2; ++bj) { const f32x4 a = acc[ai][bj][m][0], c = acc[ai][bj][m][1];
                    float s = (a[0] * a[0] + a[1] * a[1]) + (a[2] * a[2] + a[3] * a[3]) + (c[0] * c[0] + c[1] * c[1]) + (c[2] * c[2] + c[3] * c[3]);
                    s += __shfl_xor(s, 16); s += __shfl_xor(s, 32);
                    if (fqq == 0) ssq[((ai * HALF + wr * 64 + m * 16 + frq) * 2 + bj) * 4 + wc] = s; }
        asm volatile("s_waitcnt lgkmcnt(0)" ::: "memory"); __builtin_amdgcn_s_barrier(); asm volatile("" ::: "memory");
        const int idx = 4 * wc + fqq, axis = idx >> 3, f0 = (idx & 7) * 4;
        const float* gnw = pn == 0 ? k_norm : q_norm;
        const f32x4 gna = *(const f32x4*)(gnw + axis * 64 + f0), gnb = *(const f32x4*)(gnw + axis * 64 + 32 + f0);
        const bool dorope = u.pm < 64;
#pragma unroll
        for (int ai = 0; ai < 2; ++ai)
#pragma unroll
            for (int m = 0; m < 4; ++m) { const int lrow = ai * HALF + wr * 64 + m * 16 + frq;
                f32x4 c0 = {1.f, 0.f, 1.f, 0.f}, c1 = {1.f, 0.f, 1.f, 0.f};
                if (dorope) { const int t = (u.pm & 15) * 256 + lrow, pos = axis == 0 ? (t >> 6) : (t & 63);
                    const float* rp = rope + (size_t)(pos * 32 + f0) * 2; c0 = *(const f32x4*)rp; c1 = *(const f32x4*)(rp + 4); }
                bf16_t* rowp = base + (rowbase + (size_t)lrow) * ldc + colt + wc * 32 + 8 * fqq;
#pragma unroll
                for (int bj = 0; bj < 2; ++bj) { const PG8_LAS float* sp = ssq + (lrow * 2 + bj) * 4;
                    const f32x4 s4 = *(const PG8_LAS f32x4*)sp;
                    const float rstd = __builtin_amdgcn_rsqf(((s4[0] + s4[1]) + (s4[2] + s4[3])) * (1.f / 128.f) + 1e-6f);
                    const f32x4 a = acc[ai][bj][m][0] * rstd * gna, bq = acc[ai][bj][m][1] * rstd * gnb;
                    f32x4 ra, rb;
                    ra[0] = a[0] * c0[0] - bq[0] * c0[1]; rb[0] = bq[0] * c0[0] + a[0] * c0[1];
                    ra[1] = a[1] * c0[2] - bq[1] * c0[3]; rb[1] = bq[1] * c0[2] + a[1] * c0[3];
                    ra[2] = a[2] * c1[0] - bq[2] * c1[1]; rb[2] = bq[2] * c1[0] + a[2] * c1[1];
                    ra[3] = a[3] * c1[2] - bq[3] * c1[3]; rb[3] = bq[3] * c1[2] + a[3] * c1[3];
                    u32x4 w; w.x = cvt_pk_bf16(ra[0], ra[1]); w.y = cvt_pk_bf16(ra[2], ra[3]); w.z = cvt_pk_bf16(rb[0], rb[1]); w.w = cvt_pk_bf16(rb[2], rb[3]);
                    *(u32x4*)(rowp + bj * HALF) = w; } }
    }
};
template <bool FIRST> struct EpiMerge {
    static constexpr bool PERM = true, AFTER_DRAIN = false;
    const bf16_t* G; bf16_t* Y;
    __device__ __forceinline__ void operator()(const f32x4 (&acc)[2][2][4][2], const Unit& u, int wr, int wc, int fr, int fq) const {
        const int row0 = u.pm * BM + wr * 64 + fr, col0 = u.pn * BM + wc * 32 + 8 * fq;
#pragma unroll
        for (int ai = 0; ai < 2; ++ai)
#pragma unroll
            for (int m = 0; m < 4; ++m) { const size_t off = (size_t)(row0 + ai * HALF + m * 16) * 1024 + col0;
#pragma unroll
                for (int bj = 0; bj < 2; ++bj) { const u32x4 g = *(const u32x4*)(G + off + bj * HALF);
                    f32x4 v0 = acc[ai][bj][m][0], v1 = acc[ai][bj][m][1];
                    v0[0] *= sigm(lo16(g.x)); v0[1] *= sigm(hi16(g.x)); v0[2] *= sigm(lo16(g.y)); v0[3] *= sigm(hi16(g.y));
                    v1[0] *= sigm(lo16(g.z)); v1[1] *= sigm(hi16(g.z)); v1[2] *= sigm(lo16(g.w)); v1[3] *= sigm(hi16(g.w));
                    if (!FIRST) { const u32x4 y = *(const u32x4*)(Y + off + bj * HALF);
                        v0[0] += lo16(y.x); v0[1] += hi16(y.x); v0[2] += lo16(y.y); v0[3] += hi16(y.y); v1[0] += lo16(y.z); v1[1] += hi16(y.z); v1[2] += lo16(y.w); v1[3] += hi16(y.w); }
                    u32x4 w; w.x = cvt_pk_bf16(v0[0], v0[1]); w.y = cvt_pk_bf16(v0[2], v0[3]); w.z = cvt_pk_bf16(v1[0], v1[1]); w.w = cvt_pk_bf16(v1[2], v1[3]);
                    *(u32x4*)(Y + off + bj * HALF) = w; } }
    }
};
struct EpiGateRes {
    static constexpr bool PERM = false, AFTER_DRAIN = false;
    const float* base; float* out; const float* gate;
    __device__ __forceinline__ void operator()(const f32x4 (&acc)[2][2][4][2], const Unit& u, int wr, int wc, int fr, int fq) const {
        const int row0 = u.pm * BM + wr * 64 + fr, col0 = u.pn * BM + wc * 32 + 4 * fq;
        const float* gp = gate + (size_t)(u.pm >> 4) * 6144 + col0;
        f32x4 gv[2][2];
#pragma unroll
        for (int bj = 0; bj < 2; ++bj)
#pragma unroll
            for (int n = 0; n < 2; ++n) gv[bj][n] = *(const f32x4*)(gp + bj * HALF + n * 16);
#pragma unroll
        for (int ai = 0; ai < 2; ++ai)
#pragma unroll
            for (int m = 0; m < 4; ++m) { const size_t off = (size_t)(row0 + ai * HALF + m * 16) * 1024 + col0;
#pragma unroll
                for (int bj = 0; bj < 2; ++bj)
#pragma unroll
                    for (int n = 0; n < 2; ++n) { const f32x4 b = *(const f32x4*)(base + off + bj * HALF + n * 16);
                        *(f32x4*)(out + off + bj * HALF + n * 16) = b + gv[bj][n] * acc[ai][bj][m][n]; } }
    }
};
struct EpiSqRelu {
    static constexpr bool PERM = true, AFTER_DRAIN = false;
    bf16_t* H;
    __device__ __forceinline__ void operator()(const f32x4 (&acc)[2][2][4][2], const Unit& u, int wr, int wc, int fr, int fq) const {
        const int row0 = u.pm * BM + wr * 64 + fr, col0 = u.pn * BM + wc * 32 + 8 * fq;
#pragma unroll
        for (int ai = 0; ai < 2; ++ai)
#pragma unroll
            for (int m = 0; m < 4; ++m) { bf16_t* rowp = H + (size_t)(row0 + ai * HALF + m * 16) * 4096 + col0;
#pragma unroll
                for (int bj = 0; bj < 2; ++bj) { f32x4 v0 = acc[ai][bj][m][0], v1 = acc[ai][bj][m][1];
#pragma unroll
                    for (int e = 0; e < 4; ++e) { const float a = __builtin_fmaxf(v0[e], 0.f), b = __builtin_fmaxf(v1[e], 0.f); v0[e] = a * a; v1[e] = b * b; }
                    u32x4 w; w.x = cvt_pk_bf16(v0[0], v0[1]); w.y = cvt_pk_bf16(v0[2], v0[3]); w.z = cvt_pk_bf16(v1[0], v1[1]); w.w = cvt_pk_bf16(v1[2], v1[3]);
                    *(u32x4*)(rowp + bj * HALF) = w; } }
    }
};
struct InOrder {
    StaticOrder so;
    __device__ void init(int G_, int c_) { so.init(16384, 6656, G_, c_); }
    __device__ bool next(int i, Unit& u) const {
        const int L = i * so.G + so.c; if (L >= 1696) return false;
        if (L < 1664) return so.next(i, u);
        const int e = L - 1664; u.pm = 64 + (e >> 3); u.pn = e & 7; return true;
    }
    __device__ __forceinline__ void a_ready(const Unit&) const {}
    __device__ __forceinline__ void done(const Unit&) const {}
};

template <class Epi, class Sched, bool ALIGN_EPI = false, bool SP2 = false>
__device__ __forceinline__ void gemm_phase(PG8_LAS unsigned char* lds, const Gemm g, const Sched& S, const Epi& E) {
    const int tid = threadIdx.x, wid = __builtin_amdgcn_readfirstlane(tid >> 6), lane = tid & 63, wr = wid >> 2, wc = wid & 3, fr = lane & 15, fq = lane >> 4;
    const int K = g.K, nt = K / BK;
    unsigned voffA[2], voffB[2];
#pragma unroll
    for (int i = 0; i < 2; ++i) { int R, C; stage_rc(tid * 16 + i * 8192, R, C); const int Rb = Epi::PERM ? ((R & ~31) + perm32(R & 31)) : R;
        voffA[i] = (unsigned)(R * K + C) * 2u; voffB[i] = (unsigned)(Rb * K + C) * 2u; }
    const size_t kstep = (size_t)(BK * 2);
    const size_t hstep = (size_t)HALF * K * 2;
    const size_t tstep = 2 * hstep;
    const unsigned ldsw = (unsigned)wid * 1024u;
    const int aoff = lds_byte(wr * 64 + fr, fq * 8), boff = lds_byte(wc * 32 + fr, fq * 8);
#define PG8_SA(b, h) (((b) * 2 + (h)) * HTB)
#define PG8_SB(b, h) ((4 + (b) * 2 + (h)) * HTB)
#define PG8_STAGE(bufoff, gbase, voff) do { _Pragma("unroll") for (int _i = 0; _i < 2; ++_i) \
        __builtin_amdgcn_global_load_lds((const unsigned*)((const char*)(gbase) + (voff)[_i]), (PG8_LAS unsigned*)(lds + (bufoff) + ldsw + _i * 8192), 16, 0, 0); } while (0)
#define PG8_LDA(dst, b, h) do { _Pragma("unroll") for (int m = 0; m < 4; ++m) _Pragma("unroll") for (int k = 0; k < 2; ++k) dst[m][k] = *(const PG8_LAS bf16x8*)(lds + PG8_SA(b, h) + aoff + m * 2048 + k * 1024); } while (0)
#define PG8_LDB(dst, b, h) do { _Pragma("unroll") for (int n = 0; n < 2; ++n) _Pragma("unroll") for (int k = 0; k < 2; ++k) dst[n][k] = *(const PG8_LAS bf16x8*)(lds + PG8_SB(b, h) + boff + n * 2048 + k * 1024); } while (0)
#define PG8_MMA(ai, bj, At, Bt) do { __builtin_amdgcn_s_setprio(1); _Pragma("unroll") for (int m = 0; m < 4; ++m) _Pragma("unroll") for (int n = 0; n < 2; ++n) _Pragma("unroll") for (int k = 0; k < 2; ++k) \
        acc[ai][bj][m][n] = __builtin_amdgcn_mfma_f32_16x16x32_bf16(Bt[n][k], At[m][k], acc[ai][bj][m][n], 0, 0, 0); __builtin_amdgcn_s_setprio(0); } while (0)
#define PG8_WAIT_V(n) asm volatile("s_waitcnt vmcnt(" #n ")" ::: "memory")
#define PG8_WAIT_L(n) asm volatile("s_waitcnt lgkmcnt(" #n ")" ::: "memory")
#define PG8_BAR __builtin_amdgcn_s_barrier()
#define PG8_SCHED __builtin_amdgcn_sched_barrier(0)
    Unit cur, nxt; int ui = 0;
    if (!S.next(0, cur)) return;
    f32x4 acc[2][2][4][2];
#pragma unroll
    for (int a = 0; a < 2; ++a)
#pragma unroll
        for (int b = 0; b < 2; ++b)
#pragma unroll
            for (int m = 0; m < 4; ++m)
#pragma unroll
                for (int n = 0; n < 2; ++n) acc[a][b][m][n] = (f32x4){0.f, 0.f, 0.f, 0.f};
    bf16x8 At[4][2], B0[2][2], B1[2][2];
    const char* cA = (const char*)g.A + (size_t)cur.pm * tstep; const char* cB = (const char*)g.Bt + (size_t)cur.pn * tstep;
    S.a_ready(cur);
    if constexpr (SP2) {
        PG8_STAGE(PG8_SB(0, 0), cB, voffB); PG8_STAGE(PG8_SB(0, 1), cB + hstep, voffB); PG8_STAGE(PG8_SA(0, 0), cA, voffA); PG8_STAGE(PG8_SA(0, 1), cA + hstep, voffA);
        if (wr == 1) PG8_BAR;
        PG8_WAIT_V(2); PG8_BAR;
        PG8_STAGE(PG8_SB(1, 0), cB + kstep, voffB); PG8_STAGE(PG8_SA(1, 0), cA + kstep, voffA); PG8_STAGE(PG8_SB(1, 1), cB + hstep + kstep, voffB);
        PG8_WAIT_V(6); PG8_BAR;
    } else {
        PG8_STAGE(PG8_SB(0, 0), cB, voffB); PG8_STAGE(PG8_SA(0, 0), cA, voffA); PG8_STAGE(PG8_SB(0, 1), cB + hstep, voffB); PG8_STAGE(PG8_SA(0, 1), cA + hstep, voffA);
        if (wr == 1) PG8_BAR;
        PG8_WAIT_V(4); PG8_BAR;
        PG8_STAGE(PG8_SB(1, 0), cB + kstep, voffB); PG8_STAGE(PG8_SA(1, 0), cA + kstep, voffA); PG8_STAGE(PG8_SB(1, 1), cB + hstep + kstep, voffB);
        PG8_WAIT_V(6); PG8_BAR;
    }
    for (;;) {
        const bool has_next = S.next(ui + 1, nxt);
        const char* nA = has_next ? (const char*)g.A + (size_t)nxt.pm * tstep : cA; const char* nB = has_next ? (const char*)g.Bt + (size_t)nxt.pn * tstep : cB;
        for (int t = 0; t < nt; t += 2) {
            const bool last = (t == nt - 2);
            const char* a1 = cA + (size_t)(t + 1) * kstep;
            const char* a2 = last ? nA : cA + (size_t)(t + 2) * kstep; const char* b2 = last ? nB : cB + (size_t)(t + 2) * kstep;
            const char* a3 = a2 + kstep; const char* b3 = b2 + kstep;
            if (last && has_next) S.a_ready(nxt);
            if constexpr (SP2) {
            PG8_LDB(B0, 0, 0); PG8_LDB(B1, 0, 1); PG8_SCHED; PG8_LDA(At, 0, 0); PG8_STAGE(PG8_SA(1, 1), a1 + hstep, voffA);
            PG8_WAIT_V(8); PG8_WAIT_L(0); PG8_BAR; PG8_MMA(0, 0, At, B0); PG8_MMA(0, 1, At, B1); PG8_BAR; PG8_SCHED;
            PG8_LDA(At, 0, 1); PG8_STAGE(PG8_SB(0, 0), b2, voffB); PG8_STAGE(PG8_SB(0, 1), b2 + hstep, voffB); PG8_STAGE(PG8_SA(0, 0), a2, voffA);
            PG8_WAIT_V(8); PG8_WAIT_L(0); PG8_BAR; PG8_MMA(1, 0, At, B0); PG8_MMA(1, 1, At, B1); PG8_BAR; PG8_SCHED;
            PG8_LDB(B0, 1, 0); PG8_LDB(B1, 1, 1); PG8_SCHED; PG8_LDA(At, 1, 0); PG8_STAGE(PG8_SA(0, 1), a2 + hstep, voffA);
            PG8_WAIT_V(8); PG8_WAIT_L(0); PG8_BAR; PG8_MMA(0, 0, At, B0); PG8_MMA(0, 1, At, B1); PG8_BAR; PG8_SCHED;
            PG8_LDA(At, 1, 1); PG8_STAGE(PG8_SB(1, 0), b3, voffB); PG8_STAGE(PG8_SB(1, 1), b3 + hstep, voffB); PG8_STAGE(PG8_SA(1, 0), a3, voffA);
            PG8_WAIT_V(8); PG8_WAIT_L(0); PG8_BAR; PG8_MMA(1, 0, At, B0); PG8_MMA(1, 1, At, B1); PG8_BAR; PG8_SCHED;
            } else {
            PG8_LDB(B0, 0, 0); PG8_SCHED; PG8_LDA(At, 0, 0); PG8_STAGE(PG8_SA(1, 1), a1 + hstep, voffA);
            PG8_WAIT_L(8); PG8_BAR; PG8_WAIT_L(0); PG8_MMA(0, 0, At, B0); PG8_BAR; PG8_SCHED;
            PG8_LDB(B1, 0, 1); PG8_STAGE(PG8_SB(0, 0), b2, voffB);
            PG8_BAR; PG8_WAIT_L(0); PG8_MMA(0, 1, At, B1); PG8_BAR;
            PG8_LDA(At, 0, 1); PG8_STAGE(PG8_SA(0, 0), a2, voffA);
            PG8_BAR; PG8_WAIT_L(0); PG8_MMA(1, 0, At, B0); PG8_BAR; PG8_SCHED;
            PG8_STAGE(PG8_SB(0, 1), b2 + hstep, voffB);
            PG8_WAIT_V(6); PG8_BAR; PG8_MMA(1, 1, At, B1); PG8_BAR;
            PG8_LDB(B0, 1, 0); PG8_SCHED; PG8_LDA(At, 1, 0); PG8_STAGE(PG8_SA(0, 1), a2 + hstep, voffA);
            PG8_WAIT_L(8); PG8_BAR; PG8_WAIT_L(0); PG8_MMA(0, 0, At, B0); PG8_BAR; PG8_SCHED;
            PG8_LDB(B1, 1, 1); PG8_STAGE(PG8_SB(1, 0), b3, voffB);
            PG8_BAR; PG8_WAIT_L(0); PG8_MMA(0, 1, At, B1); PG8_BAR;
            PG8_LDA(At, 1, 1); PG8_STAGE(PG8_SA(1, 0), a3, voffA);
            PG8_BAR; PG8_WAIT_L(0); PG8_MMA(1, 0, At, B0); PG8_BAR; PG8_SCHED;
            PG8_STAGE(PG8_SB(1, 1), b3 + hstep, voffB);
            PG8_WAIT_V(6); PG8_BAR; PG8_MMA(1, 1, At, B1); PG8_BAR;
            }
        }
        if constexpr (ALIGN_EPI) { if (wr == 0) PG8_BAR; }
        if constexpr (!Epi::AFTER_DRAIN) { E(acc, cur, wr, wc, fr, fq); S.done(cur); }
        if (!has_next) break;
#pragma unroll
        for (int a = 0; a < 2; ++a)
#pragma unroll
            for (int b = 0; b < 2; ++b)
#pragma unroll
                for (int m = 0; m < 4; ++m)
#pragma unroll
                    for (int n = 0; n < 2; ++n) acc[a][b][m][n] = (f32x4){0.f, 0.f, 0.f, 0.f};
        cur = nxt; cA = nA; cB = nB; ++ui;
        if constexpr (ALIGN_EPI) { if (wr == 1) PG8_BAR; }
    }
    PG8_WAIT_V(0);
    if constexpr (!ALIGN_EPI) { if (wr == 0) PG8_BAR; }
    PG8_BAR;
    if constexpr (Epi::AFTER_DRAIN) { E.fused(acc, cur, wr, wc, fr, fq, lds, wid, lane); S.done(cur); }
#undef PG8_SA
#undef PG8_SB
#undef PG8_STAGE
#undef PG8_LDA
#undef PG8_LDB
#undef PG8_MMA
#undef PG8_WAIT_V
#undef PG8_WAIT_L
#undef PG8_BAR
#undef PG8_SCHED
}
}
#define GAS __attribute__((address_space(1)))
#define LAS __attribute__((address_space(3)))
typedef unsigned short bf16;
typedef unsigned v4u __attribute__((ext_vector_type(4)));
typedef float f32x4 __attribute__((ext_vector_type(4)));
typedef short bf16x8 __attribute__((ext_vector_type(8)));
typedef GAS unsigned gu32;
typedef GAS unsigned long long gu64;
#define RLX_AGENT __ATOMIC_RELAXED, __HIP_MEMORY_SCOPE_AGENT
#define LDS_WAIT() asm volatile("s_waitcnt lgkmcnt(0)" ::: "memory")
#define VM_WAIT() asm volatile("s_waitcnt vmcnt(0)" ::: "memory")
__device__ __forceinline__ unsigned long long rt() { return __builtin_amdgcn_s_memrealtime(); }
__device__ __forceinline__ unsigned pk2(float lo, float hi) { return f2bf(lo) | (f2bf(hi) << 16); }

#define XB_TMO      128
#define XB_XCNT(j)  (256  + 64 * (j))
#define XB_XSUB(j)  (1280 + 64 * (j))
#define XB_XGEN(j)  (2304 + 64 * (j))
#define XB_TOP      3328
#define XB_TOPGEN   3392
#define XCD_BAR_WORDS 3456
#define XB_SPIN_CAP (1u << 18)

__device__ __forceinline__ unsigned xb_ld(unsigned* p)              { return __hip_atomic_load(p, __ATOMIC_RELAXED, __HIP_MEMORY_SCOPE_AGENT); }
__device__ __forceinline__ unsigned xb_add(unsigned* p, unsigned v) { return __hip_atomic_fetch_add(p, v, __ATOMIC_RELAXED, __HIP_MEMORY_SCOPE_AGENT); }
__device__ __forceinline__ unsigned xb_xcc_id() { return (unsigned)__builtin_amdgcn_s_getreg((3 << 11) | 20) & 0xFu; }
#define XB_SPIN(cond, bar) do { unsigned _sp = 0; while (cond) { __builtin_amdgcn_s_sleep(1); \
    if ((++_sp & 255u) == 0u) { if (xb_ld(&(bar)[XB_TMO])) break; if (_sp > XB_SPIN_CAP) { atomicAdd(&(bar)[XB_TMO], 1u); break; } } } } while (0)

struct XcdBarrier {
    unsigned* bar; unsigned x;
    volatile LAS unsigned* st;
};

__device__ __forceinline__ XcdBarrier xcd_barrier_post(unsigned* bar, volatile LAS unsigned* st) {
    XcdBarrier b; b.bar = bar; b.x = xb_xcc_id(); b.st = st;
    if (threadIdx.x == 0) (void)xb_add(&bar[XB_XCNT(b.x)], 1u);
    return b;
}
__device__ __forceinline__ void xcd_barrier_complete(unsigned* bar, unsigned x, unsigned& nloc, unsigned& nx) {
    const unsigned G = gridDim.x * gridDim.y * gridDim.z;
    unsigned sum, cnt, mine, sp = 0u;
    for (;;) {
        sum = 0u; cnt = 0u; mine = 0u;
#pragma unroll
        for (unsigned j = 0; j < 16; ++j) { const unsigned c = xb_ld(&bar[XB_XCNT(j)]); sum += c; cnt += (c > 0u) ? 1u : 0u; mine = (j == x) ? c : mine; }
        if (sum == G) break;
        __builtin_amdgcn_s_sleep(1);
        if ((++sp & 255u) == 0u) { if (xb_ld(&bar[XB_TMO])) break; if (sp > XB_SPIN_CAP) { atomicAdd(&bar[XB_TMO], 1u); break; } }
    }
    nloc = mine > 0u ? mine : 1u; nx = cnt > 0u ? cnt : 1u;
}

__device__ __forceinline__ void xcd_barrier(const XcdBarrier& b) {
    asm volatile("s_waitcnt vmcnt(0)" ::: "memory");
    __syncthreads();
    if (threadIdx.x == 0) {
        unsigned* bar = b.bar;
        __builtin_amdgcn_s_waitcnt(0);
        unsigned nloc = b.st[0], nx = b.st[1];
        if (nloc == 0u) { xcd_barrier_complete(bar, b.x, nloc, nx); b.st[0] = nloc; b.st[1] = nx; }
        const unsigned old = xb_add(&bar[XB_XSUB(b.x)], 1u);
        const unsigned gen = old / nloc;
        if (old + 1u == (gen + 1u) * nloc) {
            __builtin_amdgcn_fence(__ATOMIC_RELEASE, "agent");
            asm volatile("s_waitcnt vmcnt(0)" ::: "memory");
            const unsigned og = xb_add(&bar[XB_TOP], 1u);
            const unsigned tg = og / nx;
            if (og + 1u == (tg + 1u) * nx) xb_add(&bar[XB_TOPGEN], 1u);
            else XB_SPIN(xb_ld(&bar[XB_TOPGEN]) == tg, bar);
            __builtin_amdgcn_fence(__ATOMIC_ACQUIRE, "agent");
            xb_add(&bar[XB_XGEN(b.x)], 1u);
            asm volatile("s_waitcnt vmcnt(0)" ::: "memory");
        } else {
            XB_SPIN(xb_ld(&bar[XB_XGEN(b.x)]) == gen, bar);
            __builtin_amdgcn_fence(__ATOMIC_ACQUIRE, "agent");
            asm volatile("s_waitcnt vmcnt(0)" ::: "memory");
        }
    }
    __syncthreads();
}

namespace att {
using bf16 = unsigned short;
constexpr int   D = 128, NW = 8, QBLK = 32, KVBLK = 64;
constexpr float SCALE = 0.088388347648318440f;
constexpr float THR = 8.f;
constexpr int SDEPTH = 2;
constexpr int LDQ = 1024, LDK = 256, LDO = 1024;
constexpr size_t SHM_V = KVBLK * D * 2, SHM_K = KVBLK * D * 2, SHM_WS = 8 * 32 * 136 * 2  , SHM_ATTN = SHM_WS + NW * 64 * 4;
using s16x4  = __attribute__((ext_vector_type(4))) short;
using f32x8  = __attribute__((ext_vector_type(8))) float;
using bf16x8 = __attribute__((ext_vector_type(8))) short;
using s16x4  = __attribute__((ext_vector_type(4))) short;
using f32x16 = __attribute__((ext_vector_type(16))) float;
using f32x8  = __attribute__((ext_vector_type(8))) float;
using u32x4  = __attribute__((ext_vector_type(4))) unsigned;
#define KSWZ(row, colB) ((row) * 256 + ((colB) ^ (((row) & 7) << 4)))
#define SBAR() __builtin_amdgcn_sched_barrier(0)
__device__ __forceinline__ unsigned cvtpk(float lo, float hi) {
  unsigned r; asm volatile("v_cvt_pk_bf16_f32 %0, %1, %2" : "=v"(r) : "v"(lo), "v"(hi)); return r;
}
template <typename TIn> struct Stage;
template <> struct Stage<bf16>  { using T = bf16x8;
  __device__ static __forceinline__ T ld8(const bf16* p) { return *reinterpret_cast<const bf16x8*>(p); }
  __device__ static __forceinline__ bf16x8 tobf(T x) { return x; } };
__device__ __forceinline__ void partialSM(f32x16& p0, f32x16& p1, float& m_reg, float& mn, float& alpha) {
  constexpr float C = SCALE * 1.4426950408889634f;
  float pmax = p0[0]; for (int r = 1; r < 16; ++r) pmax = fmaxf(pmax, p0[r]); for (int r = 0; r < 16; ++r) pmax = fmaxf(pmax, p1[r]);
  { auto rr = __builtin_amdgcn_permlane32_swap(__float_as_uint(pmax), __float_as_uint(pmax), false, false);
    pmax = fmaxf(__uint_as_float(rr[0]), __uint_as_float(rr[1])); }
  if (__builtin_expect(__all(pmax - m_reg <= THR / SCALE), 1)) { mn = m_reg; alpha = 1.f; }
  else { mn = fmaxf(m_reg, pmax); alpha = __builtin_amdgcn_exp2f((m_reg - mn) * C); m_reg = mn; }
  float mnC = -mn * C;
  for (int r = 0; r < 16; ++r) p0[r] = fmaf(p0[r], C, mnC); for (int r = 0; r < 16; ++r) p1[r] = fmaf(p1[r], C, mnC);
  for (int r = 0; r < 16; ++r) p0[r] = __builtin_amdgcn_exp2f(p0[r]);
}
__device__ __forceinline__ void finishSM(f32x16& p0, f32x16& p1, float alpha, float& l_reg, bf16x8& pa0, bf16x8& pa1, bf16x8& pa2, bf16x8& pa3) {
  for (int r = 0; r < 16; ++r) p1[r] = __builtin_amdgcn_exp2f(p1[r]);
  float ps = 0; for (int r = 0; r < 16; ++r) ps += p0[r]; for (int r = 0; r < 16; ++r) ps += p1[r];
  { auto rr = __builtin_amdgcn_permlane32_swap(__float_as_uint(ps), __float_as_uint(ps), false, false);
    ps = __uint_as_float(rr[0]) + __uint_as_float(rr[1]); }
  l_reg = l_reg * alpha + ps;
#define PK4(P, BASE, OUT) do { unsigned a0 = cvtpk(P[BASE + 0], P[BASE + 1]), a1 = cvtpk(P[BASE + 2], P[BASE + 3]);   \
    unsigned b0 = cvtpk(P[BASE + 4], P[BASE + 5]), b1 = cvtpk(P[BASE + 6], P[BASE + 7]);                              \
    auto r0 = __builtin_amdgcn_permlane32_swap(a0, b0, false, false); auto r1 = __builtin_amdgcn_permlane32_swap(a1, b1, false, false); \
    u32x4 w = {r0[0], r1[0], r0[1], r1[1]}; OUT = *reinterpret_cast<bf16x8*>(&w); } while (0)
  PK4(p0, 0, pa0); PK4(p0, 8, pa1); PK4(p1, 0, pa2); PK4(p1, 8, pa3);
#undef PK4
}
__device__ __forceinline__ void qkt(f32x16& p0, f32x16& p1, const bf16* Ks, const bf16x8* qr, int r32, int hi) {
  p0 = f32x16{}; p1 = f32x16{};
  for (int d0 = 0; d0 < 8; ++d0) { int cb = (d0 * 16 + hi * 8) * 2;
    bf16x8 b0 = *reinterpret_cast<const bf16x8*>((const char*)Ks + KSWZ(r32, cb));
    bf16x8 b1 = *reinterpret_cast<const bf16x8*>((const char*)Ks + KSWZ(32 + r32, cb));
    p0 = __builtin_amdgcn_mfma_f32_32x32x16_bf16(b0, qr[d0], p0, 0, 0, 0);
    p1 = __builtin_amdgcn_mfma_f32_32x32x16_bf16(b1, qr[d0], p1, 0, 0, 0); }
}
__device__ __forceinline__ int v_st(int k, int c) { const int kk = (k & ~0xC) | ((k & 4) << 1) | ((k & 8) >> 1); return ((kk >> 3) * 4 + (c >> 5)) * 512 + ((kk & 7) * 32 + (c & 31)) * 2; }
__device__ __forceinline__ int v_rd_base(int lane) { return ((lane & 3) << 3) | (((lane >> 2) & 3) << 6) | (((lane >> 4) & 1) << 5) | (((lane >> 5) & 1) << 8); }
constexpr int v_rd_off(int d0, int ks, int half) { return d0 * 512 + ks * 4096 + half * 2048; }
template <int OFF> __device__ __forceinline__ s16x4 tr_read(int vb) {
  s16x4 r; asm volatile("ds_read_b64_tr_b16 %0, %1 offset:%2" : "=&v"(r) : "v"(vb), "i"(OFF) : "memory"); return r;
}
template <int D0> __device__ __forceinline__ void pv_one(f32x16& od, int vb, bf16x8 pa0, bf16x8 pa1, bf16x8 pa2, bf16x8 pa3) {
  const s16x4 l0 = tr_read<v_rd_off(D0, 0, 0)>(vb), h0 = tr_read<v_rd_off(D0, 0, 1)>(vb), l1 = tr_read<v_rd_off(D0, 1, 0)>(vb), h1 = tr_read<v_rd_off(D0, 1, 1)>(vb);
  const s16x4 l2 = tr_read<v_rd_off(D0, 2, 0)>(vb), h2 = tr_read<v_rd_off(D0, 2, 1)>(vb), l3 = tr_read<v_rd_off(D0, 3, 0)>(vb), h3 = tr_read<v_rd_off(D0, 3, 1)>(vb);
  asm volatile("s_waitcnt lgkmcnt(0)" ::: "memory"); SBAR();
#define PK(L, H) (bf16x8){L[0], L[1], L[2], L[3], H[0], H[1], H[2], H[3]}
  od = __builtin_amdgcn_mfma_f32_32x32x16_bf16(pa0, PK(l0, h0), od, 0, 0, 0);
  od = __builtin_amdgcn_mfma_f32_32x32x16_bf16(pa1, PK(l1, h1), od, 0, 0, 0);
  od = __builtin_amdgcn_mfma_f32_32x32x16_bf16(pa2, PK(l2, h2), od, 0, 0, 0);
  od = __builtin_amdgcn_mfma_f32_32x32x16_bf16(pa3, PK(l3, h3), od, 0, 0, 0);
#undef PK
}
__device__ __forceinline__ void pv_d0(f32x16* o, int vb, bf16x8 pa0, bf16x8 pa1, bf16x8 pa2, bf16x8 pa3) {
  pv_one<0>(o[0], vb, pa0, pa1, pa2, pa3); pv_one<1>(o[1], vb, pa0, pa1, pa2, pa3); pv_one<2>(o[2], vb, pa0, pa1, pa2, pa3); pv_one<3>(o[3], vb, pa0, pa1, pa2, pa3);
}

template <typename TQ>
__device__ __forceinline__ void attn_dense_body(const TQ* Qb, const bf16* __restrict__ Kh, const bf16* __restrict__ Vh,
                                                bf16* Ob, int seq, char* lds) {
  using St = Stage<bf16>; using SQ = Stage<TQ>;
  const int tid = threadIdx.x, wid = tid >> 6, lane = tid & 63, r32 = lane & 31, hi = lane >> 5;
  bf16* V_lds = (bf16*)lds; bf16* K_lds = (bf16*)(lds + 2 * SHM_V);
  float* ws = (float*)(lds + SHM_WS) + wid * 64; float* li_l = ws; float* al_l = ws + 32;
  float m_reg = -1e30f, l_reg = 0; f32x16 o[4] = {}; bf16x8 qr[8];
  const TQ* Qw = Qb + (long)(wid * QBLK + r32) * LDQ + hi * 8;
#pragma unroll
  for (int d0 = 0; d0 < 8; ++d0) qr[d0] = SQ::tobf(SQ::ld8(Qw + d0 * 16));
  const int sr = tid >> 4, sc = (tid & 15) * 8, vst0 = v_st(sr, sc), vst1 = v_st(32 + sr, sc);
  const int vb0 = (int)(uintptr_t)V_lds + v_rd_base(lane);
  struct { typename St::T vs0, vs1, ks0, ks1; } sr_[SDEPTH];
#define SLOAD(i, k0) do { sr_[i].vs0 = St::ld8(&Vh[(long)((k0) + sr) * LDK + sc]); sr_[i].vs1 = St::ld8(&Vh[(long)((k0) + 32 + sr) * LDK + sc]); \
    sr_[i].ks0 = St::ld8(&Kh[(long)((k0) + sr) * LDK + sc]); sr_[i].ks1 = St::ld8(&Kh[(long)((k0) + 32 + sr) * LDK + sc]); } while (0)
#define SWRITE(b, i) do { *(bf16x8*)((char*)V_lds + (b) * SHM_V + vst0) = St::tobf(sr_[i].vs0);          \
    *(bf16x8*)((char*)V_lds + (b) * SHM_V + vst1) = St::tobf(sr_[i].vs1); int kc = sc * 2;               \
    *(bf16x8*)((char*)K_lds + (b) * SHM_K + KSWZ(sr, kc)) = St::tobf(sr_[i].ks0);                       \
    *(bf16x8*)((char*)K_lds + (b) * SHM_K + KSWZ(32 + sr, kc)) = St::tobf(sr_[i].ks1); } while (0)
#define SWAIT() do { if constexpr (SDEPTH == 2) asm volatile("s_waitcnt vmcnt(4)" ::: "memory"); else asm volatile("s_waitcnt vmcnt(0)" ::: "memory"); } while (0)
#define RESC(a) do { if (__any((a) < 1.f)) { if (hi == 0) al_l[r32] = (a); asm volatile("s_waitcnt lgkmcnt(0)" ::: "memory"); \
    for (int d = 0; d < 4; ++d) for (int r = 0; r < 16; ++r) o[d][r] *= al_l[crow(r, hi)]; } } while (0)
  f32x16 pA0, pA1, pB0, pB1; float mnA, mnB, alA, alB; bf16x8 pa0, pa1, pa2, pa3; const int NT = seq / KVBLK;
  constexpr int SE = 0, SO = SDEPTH - 1;
  SLOAD(SE, 0); asm volatile("s_waitcnt vmcnt(0)" ::: "memory"); SWRITE(0, SE); __syncthreads();
  qkt(pA0, pA1, K_lds, qr, r32, hi); partialSM(pA0, pA1, m_reg, mnA, alA);
  SLOAD(SO, KVBLK); if constexpr (SDEPTH == 2) { if (2 < NT) SLOAD(SE, 2 * KVBLK); }
  SWAIT(); SWRITE(1, SO); __syncthreads();
  for (int j = 1; j + 1 < NT; j += 2) {
    SBAR(); qkt(pB0, pB1, (bf16*)((char*)K_lds + SHM_K), qr, r32, hi);
    finishSM(pA0, pA1, alA, l_reg, pa0, pa1, pa2, pa3); SBAR();
    SLOAD(SO, (j + SDEPTH) * KVBLK); SBAR();
    pv_d0(o, vb0, pa0, pa1, pa2, pa3); partialSM(pB0, pB1, m_reg, mnB, alB);
    __syncthreads(); SWAIT(); SWRITE(0, SE);
    RESC(alB); __syncthreads();
    SBAR(); qkt(pA0, pA1, K_lds, qr, r32, hi);
    finishSM(pB0, pB1, alB, l_reg, pa0, pa1, pa2, pa3); SBAR();
    if (SDEPTH == 1 || j + 3 < NT) SLOAD(SE, (j + 1 + SDEPTH) * KVBLK); SBAR();
    pv_d0(o, vb0 + (int)SHM_V, pa0, pa1, pa2, pa3); partialSM(pA0, pA1, m_reg, mnA, alA);
    __syncthreads(); SWAIT(); SWRITE(1, SO);
    RESC(alA); __syncthreads();
  }
  SBAR(); qkt(pB0, pB1, (bf16*)((char*)K_lds + SHM_K), qr, r32, hi);
  finishSM(pA0, pA1, alA, l_reg, pa0, pa1, pa2, pa3); SBAR();
  pv_d0(o, vb0, pa0, pa1, pa2, pa3); partialSM(pB0, pB1, m_reg, mnB, alB);
  __syncthreads(); RESC(alB);
  finishSM(pB0, pB1, alB, l_reg, pa0, pa1, pa2, pa3); SBAR();
  pv_d0(o, vb0 + (int)SHM_V, pa0, pa1, pa2, pa3);
  if (hi == 0) li_l[r32] = l_reg; asm volatile("s_waitcnt lgkmcnt(0)" ::: "memory");
  float rli[16];
#pragma unroll
  for (int r = 0; r < 16; ++r) rli[r] = __builtin_amdgcn_rcpf(li_l[crow(r, hi)]);
  __syncthreads();
  int widl = wid, lanel = lane; asm volatile("" : "+v"(widl), "+v"(lanel));
  bf16* pt = (bf16*)lds + widl * (32 * 136);
#pragma unroll
  for (int r = 0; r < 16; ++r) { const int orow = crow(r, lanel >> 5);
#pragma unroll
    for (int d0 = 0; d0 < 4; ++d0) pt[orow * 136 + d0 * 32 + (lanel & 31)] = (bf16)f2bf(o[d0][r] * rli[r]); }
  asm volatile("s_waitcnt lgkmcnt(0)" ::: "memory");
  bf16* Ow = Ob + (long)(widl * QBLK) * LDO;
#pragma unroll
  for (int i = 0; i < 8; ++i) { const int row = 4 * i + (lanel >> 4), ch = lanel & 15;
    *(u32x4*)(Ow + (long)row * LDO + ch * 8) = *(const u32x4*)(pt + row * 136 + ch * 8); }
  __syncthreads();
#undef SLOAD
#undef SWRITE
#undef SWAIT
#undef RESC
}
#undef KSWZ
#undef SBAR
}

namespace gla {
typedef __attribute__((address_space(3))) unsigned char* lptr;
typedef __attribute__((address_space(3))) const char* lds_cptr;
typedef short v4i16_t __attribute__((ext_vector_type(4)));
typedef short s16x4 __attribute__((ext_vector_type(4)));
__device__ __forceinline__ s16x4 vtr(lds_cptr p) { return __builtin_bit_cast(s16x4, __builtin_amdgcn_ds_read_tr16_b64_v4i16((__attribute__((address_space(3))) v4i16_t*)p)); }
typedef float f32x2_t __attribute__((ext_vector_type(2))); typedef __bf16 bf16x2_t __attribute__((ext_vector_type(2)));
__device__ __forceinline__ unsigned cvtpk(float lo, float hi) { f32x2_t v = {lo, hi}; bf16x2_t b = __builtin_convertvector(v, bf16x2_t); return __builtin_bit_cast(unsigned, b); }
__device__ __forceinline__ float logsig16(float x) {
    const float e = __builtin_amdgcn_exp2f(-__builtin_fabsf(x) * 1.4426950408889634f);
    const float l = __builtin_amdgcn_logf(1.f + e) * 0.6931471805599453f;
    return (__builtin_fminf(x, 0.f) - l) * 0.0625f;
}
__device__ __forceinline__ float expf_(float x) { return __builtin_amdgcn_exp2f(x * 1.4426950408889634f); }

struct Ptrs {
    bf16_t* GK; const bf16_t* GV; bf16_t* GQ; bf16_t* QEB; bf16_t* KDB; float* GAM; bf16_t* AM; bf16_t* OI; bf16_t* OIB; bf16_t* GO; const float* LR;
    const float *w_gk_f, *b_gk_f, *w_gk_b, *b_gk_b, *gla_norm;
};

constexpr int G1_LR = 0, G1_TOT = 8192, G1_G = 12288, G1_GP = 68, G1_QE = G1_G, G1_PITCH = 136, G1_KE = G1_QE + 2 * 64 * G1_PITCH * 2;
constexpr int G1_RAW = G1_G + 2 * 128 * G1_GP * 4;
constexpr int G1_AM = G1_RAW + 2 * 64 * G1_PITCH * 2, G1_AMP = 72;
static_assert(G1_KE + 2 * 64 * G1_PITCH * 2 <= G1_RAW && G1_AM + 64 * G1_AMP * 2 <= 131072, "G1 LDS");
struct G1Pre { u32x4 lr, k0, k1, q0, q1; };
__device__ __forceinline__ void g1_issue(const Ptrs& p, G1Pre& n, int bh, int ci, int tid) {
    const int b = bh >> 2, h = bh & 3;
    const size_t pr0 = (size_t)b * P + (size_t)ci * 64;
    n.lr = *(const u32x4*)(p.LR + (pr0 + (tid >> 3)) * 32 + (tid & 7) * 4);
    const int row = tid >> 4, ch = tid & 15;
    n.k0 = *(const u32x4*)(p.GK + (pr0 + row) * 512 + h * 128 + ch * 8); n.k1 = *(const u32x4*)(p.GK + (pr0 + 32 + row) * 512 + h * 128 + ch * 8);
    if (ci >= 4) { const size_t m0 = (size_t)b * T + (size_t)(ci - 4) * 64;
        n.q0 = *(const u32x4*)(p.GQ + (m0 + row) * 512 + h * 128 + ch * 8); n.q1 = *(const u32x4*)(p.GQ + (m0 + 32 + row) * 512 + h * 128 + ch * 8); }
}
__device__ __forceinline__ bf16x8 bf_hi8(const float (&x)[8], float (&rem)[8]) {
    u32x4 w;
#pragma unroll
    for (int i = 0; i < 8; i += 2) { const unsigned a = f2bf(x[i]), c = f2bf(x[i + 1]); rem[i] = x[i] - __builtin_bit_cast(float, a << 16); rem[i + 1] = x[i + 1] - __builtin_bit_cast(float, c << 16); w[i >> 1] = a | (c << 16); }
    return __builtin_bit_cast(bf16x8, w);
}
__device__ __forceinline__ bf16x8 bf_pack8(const float (&x)[8]) { u32x4 w;
#pragma unroll
    for (int i = 0; i < 8; i += 2) w[i >> 1] = cvtpk(x[i], x[i + 1]);
    return __builtin_bit_cast(bf16x8, w); }
__device__ __forceinline__ void g1_unit(const Ptrs& p, int bh, int ci, const G1Pre& cur, G1Pre& nxt, bool has_next, int nbh, int nci, lptr lds, int tid) {
    typedef __attribute__((address_space(3))) float* lfp; typedef __attribute__((address_space(3))) bf16_t* lbp;
    const int b = bh >> 2, h = bh & 3, d = tid & 127, tq = tid >> 7;
    const int wave = __builtin_amdgcn_readfirstlane(tid >> 6), lane = tid & 63;
    const size_t pr0 = (size_t)b * P + (size_t)ci * 64;
    const bool isx = ci >= 4; const size_t m0 = (size_t)b * T + (size_t)(ci - 4) * 64;
    lfp LRs = (lfp)(lds + G1_LR), TOT = (lfp)(lds + G1_TOT), Gs = (lfp)(lds + G1_G);
    lbp QEs = (lbp)(lds + G1_QE), KEs = (lbp)(lds + G1_KE), Kraw = (lbp)(lds + G1_RAW), Qraw = Kraw + 64 * G1_PITCH, AMs = (lbp)(lds + G1_AM);
    *(__attribute__((address_space(3))) u32x4*)(LRs + (tid >> 3) * 32 + (tid & 7) * 4) = cur.lr;
    { const int row = tid >> 4, ch = tid & 15;
      *(__attribute__((address_space(3))) u32x4*)(Kraw + row * G1_PITCH + ch * 8) = cur.k0; *(__attribute__((address_space(3))) u32x4*)(Kraw + (32 + row) * G1_PITCH + ch * 8) = cur.k1;
      if (isx) { *(__attribute__((address_space(3))) u32x4*)(Qraw + row * G1_PITCH + ch * 8) = cur.q0; *(__attribute__((address_space(3))) u32x4*)(Qraw + (32 + row) * G1_PITCH + ch * 8) = cur.q1; } }
    const int mt = wave & 1, nt = wave >> 1, r32 = lane & 31, hi = lane >> 5;
    float wf[2][8], bias[2];
#pragma unroll
    for (int dir = 0; dir < 2; ++dir) { const float* wg = dir ? p.w_gk_b : p.w_gk_f;
#pragma unroll
        for (int j = 0; j < 8; ++j) wf[dir][j] = wg[(8 * hi + j) * 512 + h * 128 + 32 * nt + r32];
        bias[dir] = (dir ? p.b_gk_b : p.b_gk_f)[h * 128 + 32 * nt + r32]; }
    __syncthreads();
#pragma unroll
    for (int dir = 0; dir < 2; ++dir) {
        float a[8], ar[8], wr[8];
        { const f32x4 a0 = *(const __attribute__((address_space(3))) f32x4*)(LRs + (32 * mt + r32) * 32 + dir * 16 + 8 * hi), a1 = *(const __attribute__((address_space(3))) f32x4*)(LRs + (32 * mt + r32) * 32 + dir * 16 + 8 * hi + 4);
          a[0] = a0[0]; a[1] = a0[1]; a[2] = a0[2]; a[3] = a0[3]; a[4] = a1[0]; a[5] = a1[1]; a[6] = a1[2]; a[7] = a1[3]; }
        const bf16x8 ah = bf_hi8(a, ar), al = bf_pack8(ar);
        const bf16x8 bh8 = bf_hi8(wf[dir], wr), bl = bf_pack8(wr);
        f32x16 acc;
#pragma unroll
        for (int r = 0; r < 16; ++r) acc[r] = bias[dir];
        acc = __builtin_amdgcn_mfma_f32_32x32x16_bf16(ah, bh8, acc, 0, 0, 0);
        acc = __builtin_amdgcn_mfma_f32_32x32x16_bf16(al, bh8, acc, 0, 0, 0);
        acc = __builtin_amdgcn_mfma_f32_32x32x16_bf16(ah, bl, acc, 0, 0, 0);
#pragma unroll
        for (int g4 = 0; g4 < 4; ++g4) { f32x4 gv;
#pragma unroll
            for (int e = 0; e < 4; ++e) gv[e] = logsig16(acc[4 * g4 + e]);
            *(__attribute__((address_space(3))) f32x4*)(Gs + (dir * 128 + 32 * nt + r32) * G1_GP + 32 * mt + 8 * g4 + 4 * hi) = gv; }
    }
    __syncthreads();
    float cs[2][16], kv[16], qv[16];
#pragma unroll
    for (int dir = 0; dir < 2; ++dir) {
        float gl[16];
#pragma unroll
        for (int i = 0; i < 16; i += 4) { const f32x4 v = *(const __attribute__((address_space(3))) f32x4*)(Gs + (dir * 128 + d) * G1_GP + 16 * tq + i); gl[i] = v[0]; gl[i + 1] = v[1]; gl[i + 2] = v[2]; gl[i + 3] = v[3]; }
        float run = 0.f;
        if (dir == 0) {
#pragma unroll
            for (int i = 0; i < 16; ++i) { run += gl[i]; cs[0][i] = run; }
        } else {
#pragma unroll
            for (int i = 15; i >= 0; --i) { run += gl[i]; cs[1][i] = run; }
        }
        TOT[(dir * 4 + tq) * 128 + d] = run;
    }
#pragma unroll
    for (int i = 0; i < 16; ++i) { kv[i] = bf2f(Kraw[(16 * tq + i) * G1_PITCH + d]); qv[i] = isx ? bf2f(Qraw[(16 * tq + i) * G1_PITCH + d]) : 0.f; }
    if (has_next) g1_issue(p, nxt, nbh, nci, tid);
    __syncthreads();
#pragma unroll
    for (int dir = 0; dir < 2; ++dir) {
        const float t0 = TOT[(dir * 4 + 0) * 128 + d], t1 = TOT[(dir * 4 + 1) * 128 + d], t2 = TOT[(dir * 4 + 2) * 128 + d], t3 = TOT[(dir * 4 + 3) * 128 + d];
        const float btot = (t0 + t1) + (t2 + t3);
        float off;
        if (dir == 0) off = (tq > 0 ? t0 : 0.f) + (tq > 1 ? t1 : 0.f) + (tq > 2 ? t2 : 0.f);
        else          off = (tq < 1 ? t1 : 0.f) + (tq < 2 ? t2 : 0.f) + (tq < 3 ? t3 : 0.f);
        unsigned kdw[8];
#pragma unroll
        for (int i = 0; i < 16; i += 2) { const float b0 = off + cs[dir][i], b1 = off + cs[dir][i + 1];
            kdw[i >> 1] = cvtpk(kv[i] * expf_(btot - b0), kv[i + 1] * expf_(btot - b1)); }
        bf16_t* kdp = dir == 0 ? p.GK + (pr0 + (size_t)(d >> 1)) * 512 + h * 128 + (d & 1) * 64 + 16 * tq
                               : p.KDB + (((size_t)bh * NCH + ci) * 128 + d) * 64 + 16 * tq;
        *(u32x4*)kdp = (u32x4){kdw[0], kdw[1], kdw[2], kdw[3]}; *(u32x4*)(kdp + 8) = (u32x4){kdw[4], kdw[5], kdw[6], kdw[7]};
        if (tq == 0) p.GAM[(((size_t)dir * 16 + bh) * NCH + ci) * 128 + d] = expf_(btot);
        if (isx) {
#pragma unroll
            for (int i = 0; i < 16; ++i) { const float bi = off + cs[dir][i];
                QEs[(dir * 64 + 16 * tq + i) * G1_PITCH + d] = (bf16_t)f2bf(qv[i] * expf_(bi)); KEs[(dir * 64 + 16 * tq + i) * G1_PITCH + d] = (bf16_t)f2bf(kv[i] * expf_(-bi)); }
        }
    }
    __syncthreads();
    if (isx) {
#pragma unroll
        for (int dir = 0; dir < 2; ++dir)
#pragma unroll
            for (int k = 0; k < 2; ++k) { const int row = (tid >> 4) + 32 * k, ch = tid & 15;
                *(u32x4*)((dir == 0 ? p.GQ : p.QEB) + (m0 + row) * 512 + h * 128 + ch * 8) = *(const __attribute__((address_space(3))) u32x4*)(QEs + (dir * 64 + row) * G1_PITCH + ch * 8); }
        const int fr = lane & 15, fq = lane >> 4, ti = wave >> 1;
#pragma unroll
        for (int jj = 0; jj < 2; ++jj) { const int tj = 2 * (wave & 1) + jj;
            f32x4 aF = {0.f, 0.f, 0.f, 0.f}, aB = {0.f, 0.f, 0.f, 0.f};
#pragma unroll
            for (int ks = 0; ks < 4; ++ks) {
                const bf16x8 qf = *(const __attribute__((address_space(3))) bf16x8*)(QEs + (16 * ti + fr) * G1_PITCH + 32 * ks + 8 * fq);
                const bf16x8 kf = *(const __attribute__((address_space(3))) bf16x8*)(KEs + (16 * tj + fr) * G1_PITCH + 32 * ks + 8 * fq);
                const bf16x8 qb = *(const __attribute__((address_space(3))) bf16x8*)(QEs + (64 + 16 * ti + fr) * G1_PITCH + 32 * ks + 8 * fq);
                const bf16x8 kb = *(const __attribute__((address_space(3))) bf16x8*)(KEs + (64 + 16 * tj + fr) * G1_PITCH + 32 * ks + 8 * fq);
                aF = __builtin_amdgcn_mfma_f32_16x16x32_bf16(qf, kf, aF, 0, 0, 0);
                aB = __builtin_amdgcn_mfma_f32_16x16x32_bf16(qb, kb, aB, 0, 0, 0);
            }
#pragma unroll
            for (int r = 0; r < 4; ++r) { const int i = 16 * ti + 4 * fq + r, j = 16 * tj + fr;
                AMs[i * G1_AMP + j] = (bf16_t)f2bf((j <= i ? aF[r] : 0.f) + (j >= i ? aB[r] : 0.f)); }
        }
    }
    __syncthreads();
    if (isx) { const int row = tid >> 3, ch = tid & 7;
        *(u32x4*)(p.AM + ((size_t)bh * 64 + (ci - 4)) * 4096 + row * 64 + ch * 8) = *(const __attribute__((address_space(3))) u32x4*)(AMs + row * G1_AMP + ch * 8); }
}

constexpr int G2_OPB = 40960, G2_QE = 0, G2_KD = 16384, G2_V = 32768;
constexpr int G2_ST = 2 * G2_OPB, G2_STP = 136;
constexpr int G2_OT = G2_ST + 2 * 64 * G2_STP * 2;
static_assert(G2_OT + 8 * 1024 <= 131072, "G2 LDS");
struct G2Stage { u32x4 q[2], k[2], v; f32x4 gm[4]; };
template <int dir> __device__ __forceinline__ void g2_load(const Ptrs& p, G2Stage& st, int s, int w, int bh, int dvq, int lane) {
    const int b = bh >> 2, h = bh & 3, fq = lane >> 4;
    const int ci = dir == 0 ? s : (s < 4 ? 3 - s : 71 - s);
    const size_t pr0 = (size_t)b * P + (size_t)ci * 64;
    if (ci >= 4) { const size_t m0 = (size_t)b * T + (size_t)(ci - 4) * 64; const bf16_t* qb = (dir == 0 ? p.GQ : p.QEB) + m0 * 512 + h * 128;
#pragma unroll
        for (int k = 0; k < 2; ++k) { const int row = 4 * (w + 8 * k) + (lane >> 4); st.q[k] = *(const u32x4*)(qb + (size_t)row * 512 + (lane & 15) * 8); } }
#pragma unroll
    for (int k = 0; k < 2; ++k) { const int d = 8 * (w + 8 * k) + (lane >> 3);
        const bf16_t* src = dir == 0 ? p.GK + (pr0 + (size_t)(d >> 1)) * 512 + h * 128 + (d & 1) * 64 + (lane & 7) * 8
                                     : p.KDB + (((size_t)bh * NCH + ci) * 128 + d) * 64 + (lane & 7) * 8;
        st.k[k] = *(const u32x4*)src; }
    { const int row = 8 * w + (lane >> 3); st.v = *(const u32x4*)(p.GV + (pr0 + row) * 1024 + h * 256 + 64 * dvq + (lane & 7) * 8); }
    { const float* gp = p.GAM + (((size_t)dir * 16 + bh) * NCH + ci) * 128 + 64 * (w >> 2) + 4 * fq;
#pragma unroll
      for (int i = 0; i < 4; ++i) st.gm[i] = *(const f32x4*)(gp + 16 * i); }
}
template <int dir> __device__ __forceinline__ void g2_store(const G2Stage& st, int s, lptr opb, int w, int lane) {
    const int ci = dir == 0 ? s : (s < 4 ? 3 - s : 71 - s);
    if (ci >= 4) {
#pragma unroll
        for (int k = 0; k < 2; ++k) { const int row = 4 * (w + 8 * k) + (lane >> 4);
            *(__attribute__((address_space(3))) u32x4*)(opb + G2_QE + row * 256 + (((lane & 15) ^ (row & 15)) << 4)) = st.q[k]; } }
#pragma unroll
    for (int k = 0; k < 2; ++k) { const int d = 8 * (w + 8 * k) + (lane >> 3);
        *(__attribute__((address_space(3))) u32x4*)(opb + G2_KD + d * 128 + (((lane & 7) ^ ((d >> 1) & 7)) << 4)) = st.k[k]; }
    { const int row = 8 * w + (lane >> 3);
      *(__attribute__((address_space(3))) u32x4*)(opb + G2_V + row * 128 + (((lane & 7) ^ ((row >> 1) & 7)) << 4)) = st.v; }
}
#ifdef MK_DIAG
#define G2T(k) do { unsigned long long t_; asm volatile("s_memtime %0\n\ts_waitcnt lgkmcnt(0)" : "=s"(t_) :: "memory"); tacc[k] += t_ - tprev; tprev = t_; } while (0)
#define G2TARGS , unsigned long long (&tacc)[5], unsigned long long& tprev
#define G2TPASS , tacc, tprev
#else
#define G2T(k) do {} while (0)
#define G2TARGS
#define G2TPASS
#endif
template <int dir> __device__ __forceinline__ void g2_step(const Ptrs& p, int s, G2Stage& R1, G2Stage& R2, f32x4 (&S)[4], f32x4 (&gm)[4], lptr lds, int w, int bh, int dvq, int lane G2TARGS) {
    const int fr = lane & 15, fq = lane >> 4, b = bh >> 2, h = bh & 3;
    const int buf = s & 1;
    const int ci = dir == 0 ? s : (s < 4 ? 3 - s : 71 - s);
    const bool isx = ci >= 4; const size_t m0 = (size_t)b * T + (size_t)(ci - 4) * 64;
    const lptr opb = lds + buf * G2_OPB;
    __attribute__((address_space(3))) bf16_t* st = (__attribute__((address_space(3))) bf16_t*)(lds + G2_ST) + buf * 64 * G2_STP;
    const int dvb = w & 3, dh = w >> 2;
    if (isx) {
#pragma unroll
        for (int i = 0; i < 4; ++i)
            *(__attribute__((address_space(3))) u32x2*)(st + (16 * dvb + fr) * G2_STP + 64 * dh + 16 * i + 4 * fq) = (u32x2){cvtpk(S[i][0], S[i][1]), cvtpk(S[i][2], S[i][3])};
    }
    asm volatile("s_waitcnt lgkmcnt(0)" ::: "memory");
    G2T(0);
    __builtin_amdgcn_s_barrier();
    asm volatile("" ::: "memory");
    G2T(1);
    if (s + 2 < NCH) g2_load<dir>(p, R2, s + 2, w, bh, dvq, lane);
    if (isx) {
        const int tt = w & 3, dvh = w >> 2;
        bf16x8 qf[4];
#pragma unroll
        for (int u = 0; u < 4; ++u) qf[u] = *(const __attribute__((address_space(3))) bf16x8*)(opb + G2_QE + (16 * tt + fr) * 256 + (((4 * u + fq) ^ fr) << 4));
        __attribute__((address_space(3))) bf16_t* ot = (__attribute__((address_space(3))) bf16_t*)(lds + G2_OT) + w * 512;
#pragma unroll
        for (int j = 0; j < 2; ++j) {
            f32x4 acc = {0.f, 0.f, 0.f, 0.f};
#pragma unroll
            for (int u = 0; u < 4; ++u) {
                const bf16x8 sf = *(const __attribute__((address_space(3))) bf16x8*)(st + (32 * dvh + 16 * j + fr) * G2_STP + 32 * u + 8 * fq);
                acc = __builtin_amdgcn_mfma_f32_16x16x32_bf16(qf[u], sf, acc, 0, 0, 0);
            }
#pragma unroll
            for (int r = 0; r < 4; ++r) ot[(4 * fq + r) * 32 + 16 * j + fr] = (bf16_t)f2bf(acc[r]);
        }
        const u32x4 ov = *(const __attribute__((address_space(3))) u32x4*)(ot + (lane >> 2) * 32 + (lane & 3) * 8);
        *(u32x4*)((dir == 0 ? p.OI : p.OIB) + (m0 + 16 * tt + (lane >> 2)) * 1024 + h * 256 + 64 * dvq + 32 * dvh + (lane & 3) * 8) = ov;
    }
    G2T(2);
    bf16x8 vB[2];
#pragma unroll
    for (int ks = 0; ks < 2; ++ks) {
        const int r0 = 32 * ks + 8 * fq + (fr >> 2), r1 = r0 + 4, ch = 2 * dvb + ((fr & 3) >> 1), o8 = (fr & 1) * 8;
        const s16x4 l = vtr((lds_cptr)(opb + G2_V) + r0 * 128 + ((ch ^ ((r0 >> 1) & 7)) << 4) + o8), hh = vtr((lds_cptr)(opb + G2_V) + r1 * 128 + ((ch ^ ((r1 >> 1) & 7)) << 4) + o8);
        vB[ks] = (bf16x8){l[0], l[1], l[2], l[3], hh[0], hh[1], hh[2], hh[3]};
    }
#pragma unroll
    for (int i = 0; i < 4; ++i) { const int d = 64 * dh + 16 * i + fr; const lptr kr = opb + G2_KD + d * 128;
        const bf16x8 a0 = *(const __attribute__((address_space(3))) bf16x8*)(kr + (((0 + fq) ^ ((d >> 1) & 7)) << 4)), a1 = *(const __attribute__((address_space(3))) bf16x8*)(kr + (((4 + fq) ^ ((d >> 1) & 7)) << 4));
        f32x4 sv = S[i] * gm[i];
        sv = __builtin_amdgcn_mfma_f32_16x16x32_bf16(a0, vB[0], sv, 0, 0, 0); sv = __builtin_amdgcn_mfma_f32_16x16x32_bf16(a1, vB[1], sv, 0, 0, 0);
        S[i] = sv; }
    G2T(3);
    if (s + 1 < NCH) { g2_store<dir>(R1, s + 1, lds + (buf ^ 1) * G2_OPB, w, lane);
#pragma unroll
        for (int i = 0; i < 4; ++i) gm[i] = R1.gm[i]; }
    G2T(4);
}
template <int dir> __device__ __forceinline__ void g2_dir(const Ptrs& p, int bh, int dvq, lptr lds, int tid) {
    const int w = __builtin_amdgcn_readfirstlane(tid >> 6), lane = tid & 63;
    f32x4 S[4], gm[4];
#pragma unroll
    for (int i = 0; i < 4; ++i) S[i] = (f32x4){0.f, 0.f, 0.f, 0.f};
    G2Stage X, Y;
    g2_load<dir>(p, X, 0, w, bh, dvq, lane); g2_store<dir>(X, 0, lds, w, lane);
#pragma unroll
    for (int i = 0; i < 4; ++i) gm[i] = X.gm[i];
    g2_load<dir>(p, X, 1, w, bh, dvq, lane);
    static_assert(NCH % 2 == 0, "two steps per trip");
#ifdef MK_DIAG
    unsigned long long tacc[5] = {0, 0, 0, 0, 0}, tprev; asm volatile("s_memtime %0\n\ts_waitcnt lgkmcnt(0)" : "=s"(tprev) :: "memory");
#endif
    for (int s = 0; s < NCH; s += 2) {
        g2_step<dir>(p, s, X, Y, S, gm, lds, w, bh, dvq, lane G2TPASS);
        g2_step<dir>(p, s + 1, Y, X, S, gm, lds, w, bh, dvq, lane G2TPASS);
    }
    asm volatile("s_waitcnt vmcnt(0) lgkmcnt(0)" ::: "memory");
    __builtin_amdgcn_s_barrier();
#ifdef MK_DIAG
    if (blockIdx.x == 0 && w == MK_DIAG_WAVE && lane == 0) { unsigned long long* o = (unsigned long long*)p.GAM - 16384;
        for (int k = 0; k < 5; ++k) o[k] = tacc[k]; }
#endif
}
__device__ __forceinline__ void g2_unit(const Ptrs& p, int u, lptr lds, int tid) {
    const int bd = u >> 2, dvq = u & 3;
    if ((bd & 1) == 0) g2_dir<0>(p, bd >> 1, dvq, lds, tid); else g2_dir<1>(p, bd >> 1, dvq, lds, tid);
}

constexpr int G3_OL = 32768, G3_OLP = 264;
static_assert(G3_OL + 64 * G3_OLP * 4 <= 131072, "G3 LDS");
__device__ __forceinline__ void g3_unit(const Ptrs& p, int bh, int c, lptr lds, int tid) {
    const int b = bh >> 2, h = bh & 3, wave = __builtin_amdgcn_readfirstlane(tid >> 6), lane = tid & 63, r32 = lane & 31, hi = lane >> 5;
    const size_t pr0 = (size_t)b * P + (size_t)(c + 4) * 64, m0 = (size_t)b * T + (size_t)c * 64;
    { const int sr = tid >> 4, sc = (tid & 15) * 8;
#pragma unroll
      for (int tile = 0; tile < 2; ++tile)
#pragma unroll
          for (int rr = 0; rr < 2; ++rr) { const int row = sr + 32 * rr;
              const bf16x8 x = *(const bf16x8*)(p.GV + (pr0 + row) * 1024 + h * 256 + tile * 128 + sc);
              *(__attribute__((address_space(3))) bf16x8*)(lds + tile * 16384 + att::v_st(row, sc)) = x; } }
    const int erow = tid >> 5, ec = (tid & 31) * 8;
    u32x4 oi[4], ob[4], gw[4];
#pragma unroll
    for (int k = 0; k < 4; ++k) { const size_t off = (m0 + erow + 16 * k) * 1024 + h * 256 + ec;
        oi[k] = *(const u32x4*)(p.OI + off); ob[k] = *(const u32x4*)(p.OIB + off); gw[k] = *(const u32x4*)(p.GO + off); }
    const bf16_t* ap = p.AM + (((size_t)bh * 64 + c) * 64 + r32) * 64 + 8 * hi;
    bf16x8 af[2][4];
#pragma unroll
    for (int mt = 0; mt < 2; ++mt)
#pragma unroll
        for (int ks = 0; ks < 4; ++ks) af[mt][ks] = *(const bf16x8*)(ap + (size_t)mt * 32 * 64 + 16 * ks);
    __syncthreads();
    { const int tile = wave >> 2, d0 = wave & 3;
      const lds_cptr vb = (lds_cptr)lds + tile * 16384 + att::v_rd_base(lane) + d0 * 512;
      f32x16 od[2];
#pragma unroll
      for (int mt = 0; mt < 2; ++mt)
#pragma unroll
          for (int r = 0; r < 16; ++r) od[mt][r] = 0.f;
#pragma unroll
      for (int ks = 0; ks < 4; ++ks) {
          const s16x4 l = vtr(vb + ks * 4096), hh = vtr(vb + ks * 4096 + 2048);
          const bf16x8 vf = (bf16x8){l[0], l[1], l[2], l[3], hh[0], hh[1], hh[2], hh[3]};
          od[0] = __builtin_amdgcn_mfma_f32_32x32x16_bf16(af[0][ks], vf, od[0], 0, 0, 0);
          od[1] = __builtin_amdgcn_mfma_f32_32x32x16_bf16(af[1][ks], vf, od[1], 0, 0, 0);
      }
      __attribute__((address_space(3))) float* OL = (__attribute__((address_space(3))) float*)(lds + G3_OL);
#pragma unroll
      for (int mt = 0; mt < 2; ++mt)
#pragma unroll
          for (int r = 0; r < 16; ++r) OL[(32 * mt + crow(r, hi)) * G3_OLP + 32 * wave + r32] = od[mt][r];
    }
    __syncthreads();
    const __attribute__((address_space(3))) float* OL = (const __attribute__((address_space(3))) float*)(lds + G3_OL);
    const f32x4 gn0 = *(const f32x4*)(p.gla_norm + ec), gn1 = *(const f32x4*)(p.gla_norm + ec + 4);
#pragma unroll
    for (int k = 0; k < 4; ++k) {
        const f32x4 a0 = *(const __attribute__((address_space(3))) f32x4*)(OL + (erow + 16 * k) * G3_OLP + ec), a1 = *(const __attribute__((address_space(3))) f32x4*)(OL + (erow + 16 * k) * G3_OLP + ec + 4);
        float o[8];
        o[0] = a0[0] + bflo(oi[k].x) + bflo(ob[k].x); o[1] = a0[1] + bfhi(oi[k].x) + bfhi(ob[k].x); o[2] = a0[2] + bflo(oi[k].y) + bflo(ob[k].y); o[3] = a0[3] + bfhi(oi[k].y) + bfhi(ob[k].y);
        o[4] = a1[0] + bflo(oi[k].z) + bflo(ob[k].z); o[5] = a1[1] + bfhi(oi[k].z) + bfhi(ob[k].z); o[6] = a1[2] + bflo(oi[k].w) + bflo(ob[k].w); o[7] = a1[3] + bfhi(oi[k].w) + bfhi(ob[k].w);
        float ss = 0.f;
#pragma unroll
        for (int e = 0; e < 8; ++e) ss += o[e] * o[e];
        ss += __shfl_xor(ss, 1); ss += __shfl_xor(ss, 2); ss += __shfl_xor(ss, 4); ss += __shfl_xor(ss, 8); ss += __shfl_xor(ss, 16);
        const float rstd = __builtin_amdgcn_rsqf(ss * (1.f / 256.f) + EPS);
        const float g0 = bflo(gw[k].x), g1 = bfhi(gw[k].x), g2 = bflo(gw[k].y), g3 = bfhi(gw[k].y), g4 = bflo(gw[k].z), g5 = bfhi(gw[k].z), g6 = bflo(gw[k].w), g7 = bfhi(gw[k].w);
        u32x4 y;
        y.x = cvtpk(o[0] * rstd * gn0[0] * (g0 * sigmoidf_(g0)), o[1] * rstd * gn0[1] * (g1 * sigmoidf_(g1)));
        y.y = cvtpk(o[2] * rstd * gn0[2] * (g2 * sigmoidf_(g2)), o[3] * rstd * gn0[3] * (g3 * sigmoidf_(g3)));
        y.z = cvtpk(o[4] * rstd * gn1[0] * (g4 * sigmoidf_(g4)), o[5] * rstd * gn1[1] * (g5 * sigmoidf_(g5)));
        y.w = cvtpk(o[6] * rstd * gn1[2] * (g6 * sigmoidf_(g6)), o[7] * rstd * gn1[3] * (g7 * sigmoidf_(g7)));
        *(u32x4*)(p.GO + (m0 + erow + 16 * k) * 1024 + h * 256 + ec) = y;
    }
    __syncthreads();
}
}

namespace pro {
typedef __attribute__((address_space(3))) unsigned char* lptr;
typedef __attribute__((address_space(3))) float* lfp;
__device__ __forceinline__ unsigned pk2f(float lo, float hi) { return f2bf(lo) | (f2bf(hi) << 16); }

__device__ __forceinline__ void ada_item(int jb, const float* __restrict__ c, const float* __restrict__ c_ctx, const float* __restrict__ w_ada, const float* __restrict__ b_ada,
                                         float* __restrict__ MODX, float* __restrict__ MODC, lptr lds, int tid) {
    lfp SC = (lfp)lds; lfp RED = (lfp)(lds + 20480);
    for (int e = tid; e < 5120; e += 512) { const int r = e >> 10, k = e & 1023; const float x = r < 4 ? c[r * 1024 + k] : c_ctx[k]; SC[e] = x / (1.f + __expf(-x)); }
    __syncthreads();
    const int c4 = tid & 7, kk = tid >> 3;
    f32x4 acc[5];
#pragma unroll
    for (int r = 0; r < 5; ++r) acc[r] = (f32x4){0.f, 0.f, 0.f, 0.f};
#pragma unroll
    for (int i = 0; i < 16; ++i) { const int k = kk + 64 * i; const f32x4 w = *(const f32x4*)(w_ada + (size_t)k * 6144 + jb * 32 + c4 * 4);
#pragma unroll
        for (int r = 0; r < 5; ++r) acc[r] += w * SC[r * 1024 + k]; }
#pragma unroll
    for (int r = 0; r < 5; ++r) *(__attribute__((address_space(3))) f32x4*)(RED + (kk * 5 + r) * 32 + c4 * 4) = acc[r];
    __syncthreads();
    if (tid < 160) { const int r = tid >> 5, jl = tid & 31, j = jb * 32 + jl; float s = 0.f;
        for (int q = 0; q < 64; ++q) s += RED[(q * 5 + r) * 32 + jl];
        s += b_ada[j];
        if (r < 4) MODX[r * 6144 + j] = s; else if (j < 2048) MODC[j] = s; }
    __syncthreads();
}
__device__ __forceinline__ void conv_item(const float* __restrict__ W, int K, int N, int src_n0, bf16_t* __restrict__ WT, int dst_n0, int k0, lfp scr, int lane, bool ropeperm = false) {
    float t[32];
    const int nl = lane & 31, scol = ropeperm ? 32 * ((nl & 7) >> 2) + 4 * (nl >> 3) + (nl & 3) : nl;
    if (src_n0 >= 0) { const float* wp = W + (size_t)(k0 + (lane >> 5)) * N + src_n0 + scol;
#pragma unroll
        for (int i = 0; i < 32; ++i) t[i] = wp[(size_t)(2 * i) * N]; }
    else {
#pragma unroll
        for (int i = 0; i < 32; ++i) t[i] = 0.f; }
#pragma unroll
    for (int i = 0; i < 32; ++i) scr[(2 * i + (lane >> 5)) * 33 + (lane & 31)] = t[i];
    asm volatile("s_waitcnt lgkmcnt(0)" ::: "memory");
    const int c = lane & 7;
#pragma unroll
    for (int j = 0; j < 4; ++j) { const int n = (lane >> 3) + 8 * j; const lfp s = scr + (8 * c) * 33 + n;
        u32x4 o; o.x = pk2f(s[0 * 33], s[1 * 33]); o.y = pk2f(s[2 * 33], s[3 * 33]); o.z = pk2f(s[4 * 33], s[5 * 33]); o.w = pk2f(s[6 * 33], s[7 * 33]);
        *(u32x4*)(WT + (size_t)(dst_n0 + n) * K + k0 + 8 * c) = o; }
    asm volatile("s_waitcnt lgkmcnt(0)" ::: "memory");
}
struct Weights { const float *w_in, *wa, *wg, *wo, *w1, *w2; bf16_t *WinT, *WaT, *WgT, *WoT, *W1T, *W2T; };
constexpr int I_IN = 16 * 210, I_SQ = 16 * 32, I_W1 = 16 * 128, I_W2 = 64 * 32, I_ALL = I_IN + 3 * I_SQ + I_W1 + I_W2;
constexpr int I_PRO = I_IN + 3 * I_SQ;
__device__ __forceinline__ void conv_any(const Weights& w, int it, lfp scr, int lane) {
    if (it < I_IN) { const int kb = it / 210, nb = it % 210, nd = 32 * nb; const bool rp = nd < 256 || (nd >= 2048 && nd < 3072);
        int src = win_src_col(nd); if (rp) { const int wc = nb & 3; src = win_src_col(nd & ~127) + 64 * (wc >> 1) + 16 * (wc & 1); }
        conv_item(w.w_in, 1024, 6688, src, w.WinT, nd, 64 * kb, scr, lane, rp); return; } it -= I_IN;
    if (it < I_SQ) { conv_item(w.wa, 1024, 1024, 32 * (it & 31), w.WaT, 32 * (it & 31), 64 * (it >> 5), scr, lane); return; } it -= I_SQ;
    if (it < I_SQ) { conv_item(w.wg, 1024, 1024, 32 * (it & 31), w.WgT, 32 * (it & 31), 64 * (it >> 5), scr, lane); return; } it -= I_SQ;
    if (it < I_SQ) { conv_item(w.wo, 1024, 1024, 32 * (it & 31), w.WoT, 32 * (it & 31), 64 * (it >> 5), scr, lane); return; } it -= I_SQ;
    if (it < I_W1) { conv_item(w.w1, 1024, 4096, 32 * (it & 127), w.W1T, 32 * (it & 127), 64 * (it >> 7), scr, lane); return; } it -= I_W1;
    conv_item(w.w2, 4096, 1024, 32 * (it & 31), w.W2T, 32 * (it & 31), 64 * (it >> 5), scr, lane);
}
__device__ __forceinline__ void norm_mod_row(const float* __restrict__ xr, const float* __restrict__ gw, const float* __restrict__ sh, const float* __restrict__ sc, bf16_t* __restrict__ orow, int lane) {
    f32x4 v[4]; float s = 0.f;
#pragma unroll
    for (int j = 0; j < 4; ++j) { v[j] = *(const f32x4*)(xr + 4 * lane + 256 * j); s += (v[j][0] * v[j][0] + v[j][1] * v[j][1]) + (v[j][2] * v[j][2] + v[j][3] * v[j][3]); }
    const float r = __builtin_amdgcn_rsqf(wave_sum(s) * (1.f / 1024.f) + EPS);
#pragma unroll
    for (int j = 0; j < 4; ++j) { const int k = 4 * lane + 256 * j; const f32x4 g = *(const f32x4*)(gw + k), a = *(const f32x4*)(sc + k), b = *(const f32x4*)(sh + k);
        const f32x4 y = (v[j] * r * g) * (a + 1.f) + b;
        *(u32x2*)(orow + k) = (u32x2){pk2f(y[0], y[1]), pk2f(y[2], y[3])}; }
}
__device__ __forceinline__ void norm_mod_rows8(const float* __restrict__ xr, const float* __restrict__ gw, const float* __restrict__ sh, const float* __restrict__ sc, bf16_t* __restrict__ orow, int lane) {
    f32x4 A[4], B[4];
#pragma unroll
    for (int j = 0; j < 4; ++j) { const int k = 4 * lane + 256 * j; const f32x4 g = *(const f32x4*)(gw + k), a = *(const f32x4*)(sc + k); A[j] = g * (a + 1.f); B[j] = *(const f32x4*)(sh + k); }
#pragma unroll 1
    for (int grp = 0; grp < 4; ++grp) {
        f32x4 v[2][4]; float s[2];
#pragma unroll
        for (int r = 0; r < 2; ++r)
#pragma unroll
            for (int j = 0; j < 4; ++j) v[r][j] = *(const f32x4*)(xr + (size_t)(grp * 2 + r) * 1024 + 4 * lane + 256 * j);
#pragma unroll
        for (int r = 0; r < 2; ++r) { s[r] = 0.f;
#pragma unroll
            for (int j = 0; j < 4; ++j) s[r] += (v[r][j][0] * v[r][j][0] + v[r][j][1] * v[r][j][1]) + (v[r][j][2] * v[r][j][2] + v[r][j][3] * v[r][j][3]); }
#pragma unroll
        for (int o = 1; o < 64; o <<= 1) {
#pragma unroll
            for (int r = 0; r < 2; ++r) s[r] += __shfl_xor(s[r], o); }
#pragma unroll
        for (int r = 0; r < 2; ++r) { const float rr = __builtin_amdgcn_rsqf(s[r] * (1.f / 1024.f) + EPS);
#pragma unroll
            for (int j = 0; j < 4; ++j) { const f32x4 y = (v[r][j] * rr) * A[j] + B[j];
                *(u32x2*)(orow + (size_t)(grp * 2 + r) * 1024 + 4 * lane + 256 * j) = (u32x2){pk2f(y[0], y[1]), pk2f(y[2], y[3])}; } }
    }
}
__device__ __forceinline__ void qkrope_chunk(bf16_t* __restrict__ chunk, const float* __restrict__ gw, const float* __restrict__ rope, int pos, bool dorope, int lane) {
    const int sub = lane & 7;
    bf16_t* p = chunk + (lane >> 3) * 128 + sub * 16;
    const u32x4 w0 = *(const u32x4*)p, w1 = *(const u32x4*)(p + 8);
    float v[16];
    v[0] = bflo(w0.x); v[1] = bfhi(w0.x); v[2] = bflo(w0.y); v[3] = bfhi(w0.y); v[4] = bflo(w0.z); v[5] = bfhi(w0.z); v[6] = bflo(w0.w); v[7] = bfhi(w0.w);
    v[8] = bflo(w1.x); v[9] = bfhi(w1.x); v[10] = bflo(w1.y); v[11] = bfhi(w1.y); v[12] = bflo(w1.z); v[13] = bfhi(w1.z); v[14] = bflo(w1.w); v[15] = bfhi(w1.w);
    float s = 0.f;
#pragma unroll
    for (int i = 0; i < 16; ++i) s += v[i] * v[i];
    s += __shfl_xor(s, 1); s += __shfl_xor(s, 2); s += __shfl_xor(s, 4);
    const float r = __builtin_amdgcn_rsqf(s * (1.f / 128.f) + EPS);
#pragma unroll
    for (int i = 0; i < 16; i += 4) { const f32x4 g = *(const f32x4*)(gw + sub * 16 + i); v[i] *= r * g[0]; v[i + 1] *= r * g[1]; v[i + 2] *= r * g[2]; v[i + 3] *= r * g[3]; }
    if (dorope) {
        const int axis = sub >> 2, half = (sub >> 1) & 1, f0 = (sub & 1) * 16;
        const int ap = axis == 0 ? (pos >> 6) : (pos & 63);
        const float* rp = rope + (size_t)(ap * 32 + f0) * 2;
#pragma unroll
        for (int i = 0; i < 16; i += 2) { const f32x4 cs = *(const f32x4*)(rp + 2 * i);
            const float q0 = __shfl_xor(v[i], 2), q1 = __shfl_xor(v[i + 1], 2);
            v[i] = half == 0 ? v[i] * cs[0] - q0 * cs[1] : v[i] * cs[0] + q0 * cs[1];
            v[i + 1] = half == 0 ? v[i + 1] * cs[2] - q1 * cs[3] : v[i + 1] * cs[2] + q1 * cs[3]; }
    }
    *(u32x4*)p = (u32x4){pk2f(v[0], v[1]), pk2f(v[2], v[3]), pk2f(v[4], v[5]), pk2f(v[6], v[7])};
    *(u32x4*)(p + 8) = (u32x4){pk2f(v[8], v[9]), pk2f(v[10], v[11]), pk2f(v[12], v[13]), pk2f(v[14], v[15])};
}
}


constexpr int RING_OFF = 0, RING_BYTES = 131072;
constexpr int LDSCTL_OFF = 163328, MISC_OFF = LDSCTL_OFF + 320;
constexpr int LDS_BYTES = 163840;
constexpr int NWAVES = 8;
constexpr int CW_BAR = 4096;

enum Phase { PH_PRO = 0, PH_NORM1, PH_INPROJ, PH_ATTN, PH_G1, PH_G2M, PH_G3, PH_MERGEB, PH_OUT, PH_NORM2, PH_MLP1, PH_MLP2, PH_END };

struct Args { const float* in[21]; float* out; unsigned char* ws; int ph_lo, ph_hi; };

__device__ __forceinline__ void lr_unit(const bf16_t* __restrict__ XNall, const bf16_t* __restrict__ WlrT, float* __restrict__ LR, int u, int wave, int lane) {
    const int r32 = lane & 31, hi = lane >> 5;
    const bf16_t* ap = XNall + (size_t)(u * 256 + wave * 32 + r32) * 1024 + hi * 8;
    const bf16_t* bp = WlrT + (size_t)r32 * 1024 + hi * 8;
    f32x16 acc;
#pragma unroll
    for (int r = 0; r < 16; ++r) acc[r] = 0.f;
#pragma unroll 8
    for (int k0 = 0; k0 < 1024; k0 += 16) {
        const bf16x8 a = *(const bf16x8*)(ap + k0), b = *(const bf16x8*)(bp + k0);
        acc = __builtin_amdgcn_mfma_f32_32x32x16_bf16(a, b, acc, 0, 0, 0);
    }
#pragma unroll
    for (int r = 0; r < 16; ++r) { const int m = u * 256 + wave * 32 + crow(r, hi); LR[prow(m) * 32 + r32] = acc[r]; }
}

__global__ void __launch_bounds__(NWAVES * 64, 2) mk_fwd(Args args) {
    extern __shared__ __attribute__((aligned(16))) unsigned char lds[];
    LAS unsigned char* ldsl = (LAS unsigned char*)lds;
    volatile LAS unsigned* MISC = (volatile LAS unsigned*)(ldsl + MISC_OFF);
    const int tid = threadIdx.x, lane = tid & 63, wave = __builtin_amdgcn_readfirstlane(tid >> 6);
    const int G = gridDim.x, bx = blockIdx.x;
    unsigned char* ws = args.ws;
    gu32* ctl = (gu32*)(ws + WS_CTL);
#define PHASE_BASES unsigned char* wsp = ws; unsigned char* dop = (unsigned char*)args.out
#define WP(T, off) ((T*)(wsp + (off)))
#define MODX WP(float, WS_MODX)
#define WinT WP(bf16_t, WS_WIN)
#define WaT WP(bf16_t, WS_WA)
#define WgT WP(bf16_t, WS_WG)
#define WoT WP(bf16_t, WS_WO)
#define W1T WP(bf16_t, WS_W1)
#define W2T WP(bf16_t, WS_W2)
#define KA WP(bf16_t, WS_KA)
#define VA WP(bf16_t, WS_VA)
#define GK WP(bf16_t, WS_GK)
#define GV WP(bf16_t, WS_GV)
#define LR WP(float, WS_LR)
#define QA WP(bf16_t, WS_QA)
#define GQ WP(bf16_t, WS_GQ)
#define GO WP(bf16_t, WS_GO)
#define GA WP(bf16_t, WS_GA)
#define GG WP(bf16_t, WS_GG)
#define Y WP(bf16_t, WS_Y)
#define HN WP(bf16_t, WS_HN)
#define H WP(bf16_t, WS_H)
#define XN ((bf16_t*)dop)
#define OUTP ((float*)dop)
#define GLA_PTRS gla::Ptrs gp{GK, GV, GQ, WP(bf16_t, WS_QEB), WP(bf16_t, WS_KDB), WP(float, WS_GAM), WP(bf16_t, WS_AM), (bf16_t*)(dop + DO_OI), (bf16_t*)(dop + DO_OIB), GO, LR, args.in[10], args.in[11], args.in[12], args.in[13], args.in[14]}
    for (int u = tid; u < (LDS_BYTES - LDSCTL_OFF) / 4; u += NWAVES * 64) ((LAS unsigned*)(ldsl + LDSCTL_OFF))[u] = 0u;
    __syncthreads();
    const int lo = args.ph_lo, hi = args.ph_hi;
    const bool multi = (hi - lo) > 1;
    XcdBarrier bar; bar.bar = (unsigned*)(ctl + CW_BAR); bar.x = 0; bar.st = nullptr;
    if (multi) bar = xcd_barrier_post((unsigned*)(ctl + CW_BAR), MISC + 8);
#define IN(k) (lo <= (k) && (k) < hi)
#ifdef MK_DIAG
#define STAMP(k) do { if (bx == 0 && tid == 0) ((unsigned long long*)(ws + WS_CTL + 8192))[(k)] = __builtin_amdgcn_s_memrealtime(); } while (0)
#else
#define STAMP(k) do {} while (0)
#endif
#define SEAM(k) do { if (IN(k) && IN((k) + 1)) xcd_barrier(bar); STAMP((k) + 1); } while (0)
    STAMP(0);

    if (IN(PH_PRO)) { PHASE_BASES;
        for (int jb = bx; jb < 192; jb += G) pro::ada_item(jb, args.in[1], args.in[3], args.in[4], args.in[5], MODX, WP(float, WS_MODC), ldsl + RING_OFF, tid);
        if (bx == G - 1) { float* rope = WP(float, WS_ROPE);
            for (int i = tid; i < 64 * 32; i += NWAVES * 64) { const int pos = i >> 5, f = i & 31; const float ang = (float)pos * powf(10000.f, -(float)(2 * f) / 64.f); rope[2 * i] = cosf(ang); rope[2 * i + 1] = sinf(ang); } }
        const pro::Weights W{args.in[7], args.in[15], args.in[16], args.in[17], args.in[19], args.in[20], WinT, WaT, WgT, WoT, W1T, W2T};
        for (int it = bx * NWAVES + wave; it < pro::I_PRO; it += G * NWAVES) pro::conv_any(W, it, (pro::lfp)(ldsl + RING_OFF + wave * 16384), lane);
    }
    SEAM(PH_PRO);
    if (IN(PH_NORM1)) { PHASE_BASES;
        const float* MODC = WP(const float, WS_MODC);
        for (int blk = bx * NWAVES + wave; blk < MALL / 8; blk += G * NWAVES) { const int row = 8 * blk;
            if (row < M) { const float* sh = MODX + (size_t)(row >> 12) * 6144; pro::norm_mod_rows8(args.in[0] + (size_t)row * DM, args.in[6], sh, sh + DM, XN + (size_t)row * DM, lane); }
            else pro::norm_mod_rows8(args.in[2] + (size_t)(row - M) * DM, args.in[6], MODC, MODC + DM, XN + (size_t)row * DM, lane);
        }
    }
    SEAM(PH_NORM1);
    if (IN(PH_INPROJ)) { PHASE_BASES;
        pg8::Gemm g{XN, WinT, MALL, NIN, DM}; pg8::InOrder S; S.init(G, bx);
        pg8::EpiInProj E{KA, VA, GK, GV, QA, GQ, GO, GA, GG, args.in[8], args.in[9], WP(const float, WS_ROPE), (LAS float*)(ldsl + RING_BYTES)};
        pg8::gemm_phase<pg8::EpiInProj, pg8::InOrder, true, true>(ldsl + RING_OFF, g, S, E);
        if (bx >= 160 && bx < 160 + 68) lr_unit(XN, WinT + (size_t)NIN * DM, LR, bx - 160, wave, lane);
    }
    SEAM(PH_INPROJ);
    if (IN(PH_ATTN)) { PHASE_BASES;
        for (int L = bx; L < 512; L += G) { const int xg = L & 7, u = L >> 3, b = xg >> 1, kvh = xg & 1, h = kvh * 4 + (u >> 4), qb = u & 15;
            bf16_t* Qb = QA + ((size_t)(b * T + qb * 256)) * 1024 + h * 128;
            att::attn_dense_body<att::bf16>(Qb, KA + (size_t)b * P * 256 + kvh * 128, VA + (size_t)b * P * 256 + kvh * 128, Qb, P, (char*)lds + RING_OFF); }
    }
    SEAM(PH_ATTN);
    if (IN(PH_G1)) { PHASE_BASES; GLA_PTRS;
        gla::G1Pre A, B; if (bx < 16 * NCH) gla::g1_issue(gp, A, bx & 15, bx >> 4, tid);
        for (int L = bx; L < 16 * NCH; L += 2 * G) {
            const int L1 = L + G, L2 = L + 2 * G;
            gla::g1_unit(gp, L & 15, L >> 4, A, B, L1 < 16 * NCH, L1 & 15, L1 >> 4, ldsl + RING_OFF, tid);
            if (L1 < 16 * NCH) gla::g1_unit(gp, L1 & 15, L1 >> 4, B, A, L2 < 16 * NCH, L2 & 15, L2 >> 4, ldsl + RING_OFF, tid);
        }
        __syncthreads();
    }
    SEAM(PH_G1);
    if (IN(PH_G2M)) { PHASE_BASES;
        const int NG2 = G >= 256 ? 128 : 0;
        if (bx < NG2) { GLA_PTRS; const int j = bx >> 3; gla::g2_unit(gp, ((bx & 7) * 4 + (j >> 2)) * 4 + (j & 3), ldsl + RING_OFF, tid); }
        else {
            if (NG2 == 0) { GLA_PTRS; for (int u = bx; u < 128; u += G) gla::g2_unit(gp, u, ldsl + RING_OFF, tid); }
            pg8::Gemm g{QA, WaT, M, DM, DM}; pg8::StaticOrder S; S.init(M, DM, G - NG2, bx - NG2); pg8::EpiMerge<true> E{Y, Y};
            pg8::gemm_phase<pg8::EpiMerge<true>, pg8::StaticOrder, true, true>(ldsl + RING_OFF, g, S, E);
        }
    }
    SEAM(PH_G2M);
    if (IN(PH_G3)) { PHASE_BASES; GLA_PTRS; for (int L = bx; L < 1024; L += G) gla::g3_unit(gp, L & 15, L >> 4, ldsl + RING_OFF, tid);
        const pro::Weights W{args.in[7], args.in[15], args.in[16], args.in[17], args.in[19], args.in[20], WinT, WaT, WgT, WoT, W1T, W2T};
        for (int it = pro::I_PRO + bx * NWAVES + wave; it < pro::I_ALL; it += G * NWAVES) pro::conv_any(W, it, (pro::lfp)(ldsl + RING_OFF + 65536 + wave * 8448), lane);
    }
    SEAM(PH_G3);
    if (IN(PH_MERGEB)) { PHASE_BASES;
        pg8::Gemm g{GO, WgT, M, DM, DM}; pg8::StaticOrder S; S.init(M, DM, G, bx); pg8::EpiMerge<false> E{GG, Y};
        pg8::gemm_phase<pg8::EpiMerge<false>, pg8::StaticOrder, false, true>(ldsl + RING_OFF, g, S, E);
    }
    SEAM(PH_MERGEB);
    if (IN(PH_OUT)) { PHASE_BASES;
        pg8::Gemm g{Y, WoT, M, DM, DM}; pg8::StaticOrder S; S.init(M, DM, G, bx); pg8::EpiGateRes E{args.in[0], OUTP, MODX + 2 * DM};
        pg8::gemm_phase<pg8::EpiGateRes, pg8::StaticOrder, false, true>(ldsl + RING_OFF, g, S, E);
    }
    SEAM(PH_OUT);
    if (IN(PH_NORM2)) { PHASE_BASES;
        for (int blk = bx * NWAVES + wave; blk < M / 8; blk += G * NWAVES) { const int row = 8 * blk; const float* sh = MODX + (size_t)(row >> 12) * 6144 + 3 * DM;
            pro::norm_mod_rows8(OUTP + (size_t)row * DM, args.in[18], sh, sh + DM, HN + (size_t)row * DM, lane); }
    }
    SEAM(PH_NORM2);
    if (IN(PH_MLP1)) { PHASE_BASES;
        pg8::Gemm g{HN, W1T, M, FF, DM}; pg8::StaticOrder S; S.init(M, FF, G, bx); pg8::EpiSqRelu E{H};
        pg8::gemm_phase<pg8::EpiSqRelu, pg8::StaticOrder, true, true>(ldsl + RING_OFF, g, S, E);
    }
    SEAM(PH_MLP1);
    if (IN(PH_MLP2)) { PHASE_BASES;
        pg8::Gemm g{H, W2T, M, DM, FF}; pg8::StaticOrder S; S.init(M, DM, G, bx); pg8::EpiGateRes E{OUTP, OUTP, MODX + 5 * DM};
        pg8::gemm_phase<pg8::EpiGateRes, pg8::StaticOrder, false, true>(ldsl + RING_OFF, g, S, E);
    }
#ifdef MK_DIAG
    {
        asm volatile("s_waitcnt vmcnt(0)" ::: "memory"); __syncthreads();
        xcd_barrier(bar);
        STAMP(PH_END);
        asm volatile("s_waitcnt vmcnt(0)" ::: "memory"); __syncthreads();
        const unsigned long long* ts = (const unsigned long long*)(ws + WS_CTL + 8192);
#ifdef MK_DIAG_G2SEG
        const float dA = (float)__hip_atomic_load((const unsigned long long*)(ws + WS_GAM - 131072) + MK_DIAG_G2SEG, __ATOMIC_RELAXED, __HIP_MEMORY_SCOPE_AGENT) * 1e-3f;
#else
        const float dA = (float)(__hip_atomic_load(ts + MK_DIAG_A + 1, __ATOMIC_RELAXED, __HIP_MEMORY_SCOPE_AGENT) - __hip_atomic_load(ts + MK_DIAG_A, __ATOMIC_RELAXED, __HIP_MEMORY_SCOPE_AGENT)) * 0.01f;
#endif
        const float dB = MK_DIAG_B >= 0 ? (float)(__hip_atomic_load(ts + MK_DIAG_B + 1, __ATOMIC_RELAXED, __HIP_MEMORY_SCOPE_AGENT) - __hip_atomic_load(ts + MK_DIAG_B, __ATOMIC_RELAXED, __HIP_MEMORY_SCOPE_AGENT)) * 0.01f : 100.f;
        pg8::StaticOrder S; S.init(M, DM, G, bx); pg8::Unit u; S.next(0, u);
        float* out = args.out; for (int e = tid; e < 65536; e += NWAVES * 64) out[(size_t)(u.pm * 256 + (e >> 8)) * 1024 + u.pn * 256 + (e & 255)] += dB * MK_DIAG_SB;
        asm volatile("s_waitcnt vmcnt(0)" ::: "memory"); __syncthreads();
        if (bx == 0 && tid == 0) out[0] += dA * 0.01f;
    }
#endif
#undef IN
#undef SEAM
}

extern "C" void kernel_launch(void* const* d_in, const int* in_sizes, int n_in, void* d_out, int out_size, void* d_ws, size_t ws_size, hipStream_t stream) {
    (void)in_sizes; (void)n_in; (void)out_size; (void)ws_size;
    static int grid = 0;
    if (grid == 0) {
        int dev = 0, cus = 0, per_cu = 0;
        if (hipGetDevice(&dev) != hipSuccess || hipDeviceGetAttribute(&cus, hipDeviceAttributeMultiprocessorCount, dev) != hipSuccess) { fprintf(stderr, "kernel_launch: device query failed\n"); grid = -1; return; }
        if (hipFuncSetAttribute((const void*)mk_fwd, hipFuncAttributeMaxDynamicSharedMemorySize, LDS_BYTES) != hipSuccess) { fprintf(stderr, "kernel_launch: hipFuncSetAttribute failed\n"); grid = -1; return; }
        if (hipOccupancyMaxActiveBlocksPerMultiprocessor(&per_cu, (const void*)mk_fwd, NWAVES * 64, LDS_BYTES) != hipSuccess || per_cu < 1) { fprintf(stderr, "kernel_launch: occupancy query says %d blocks/CU\n", per_cu); per_cu = 1; }
        (void)hipGetLastError();
        grid = cus;
        if (grid != 256) fprintf(stderr, "kernel_launch: %d CUs (built for 256)\n", grid);
    }
    if (grid < 0) return;
    unsigned char* ws = (unsigned char*)d_ws; float* out = (float*)d_out;
    (void)hipMemsetAsync(ws + WS_CTL, 0, CTL_ZERO_BYTES, stream);
    Args a{}; for (int i = 0; i < 21; ++i) a.in[i] = (const float*)d_in[i]; a.out = out; a.ws = ws;
#ifndef MK_PER_PHASE
    a.ph_lo = 0; a.ph_hi = PH_END; hipLaunchKernelGGL(mk_fwd, dim3(grid), dim3(NWAVES * 64), LDS_BYTES, stream, a);
#else
    for (int p = 0; p < PH_END; ++p) { a.ph_lo = p; a.ph_hi = p + 1; hipLaunchKernelGGL(mk_fwd, dim3(grid), dim3(NWAVES * 64), LDS_BYTES, stream, a); }
#endif
    const hipError_t le = hipPeekAtLastError();
    if (le != hipSuccess) fprintf(stderr, "kernel_launch: launch failed: %s\n", hipGetErrorName(le));
}
```
